# Optimizing an MI355X kernel written in HIP

```python
import jax, jax.numpy as jnp
from jax import lax
import numpy as np

D_MODEL = 2048
BATCH = 16
SEQ = 256
DEPTH = 1
DEC_BATCH = 8
DEC_SEQ = 2048
PAST_LEN = 256

GRID_W = 64
N_DIR = 2
M_WIDTH = D_MODEL // 2
M_HEADS = 4
M_DK = M_WIDTH // M_HEADS
R_WIDTH = D_MODEL - M_WIDTH
R_N = 64
R_HEADS = R_WIDTH // R_N
LORA = 64
CONV_K = 3
CHUNK = 64
EPS = 1e-6
LNX_EPS = 64e-5
M_GATE_COLS = N_DIR * 2 * M_HEADS
SHIFT_COLS = 3 * R_WIDTH + 2 * N_DIR * LORA
IN_COLS = 5 * M_WIDTH + M_GATE_COLS + R_WIDTH + SHIFT_COLS

kernel_name = "hybrid_mlstm_rwkv7_diffusion_step"


def _split(a, sizes):
    return jnp.split(a, np.cumsum(sizes)[:-1].tolist(), axis=-1)


def rmsnorm(x, g):
    xf = x.astype(jnp.float32)
    y = xf * lax.rsqrt(jnp.mean(xf * xf, axis=-1, keepdims=True) + EPS)
    return (y * g.astype(jnp.float32)).astype(x.dtype)


def centred_conv(p, w, b):
    pad = CONV_K // 2
    T = p.shape[1]
    pp = jnp.pad(p, ((0, 0), (pad, pad), (0, 0)))
    return sum(pp[:, j:j + T] * w[j] for j in range(CONV_K)) + b


def shift_seq(p):
    B, T, C = p.shape
    p4 = p.reshape(B, T, C // 4, 4)
    prev = jnp.pad(p4, ((0, 0), (1, 0), (0, 0), (0, 0)))[:, :T]
    nxt = jnp.pad(p4, ((0, 0), (0, 1), (0, 0), (0, 0)))[:, 1:]
    sel = (jnp.arange(4) % 2) == 0
    return jnp.where(sel, prev, nxt).reshape(B, T, C)


def shift_grid(p):
    B, T, C = p.shape
    rows = T // GRID_W
    g = p.reshape(B, rows, GRID_W, C // 4, 4)
    z2 = ((0, 0), (0, 0), (1, 0), (0, 0))
    left = jnp.pad(g[..., 0], z2)[:, :, :GRID_W]
    right = jnp.pad(g[..., 1], ((0, 0), (0, 0), (0, 1), (0, 0)))[:, :, 1:]
    up = jnp.pad(g[..., 2], ((0, 0), (1, 0), (0, 0), (0, 0)))[:, :rows]
    down = jnp.pad(g[..., 3], ((0, 0), (0, 1), (0, 0), (0, 0)))[:, 1:]
    return jnp.stack([left, right, up, down], axis=-1).reshape(B, T, C)


def mlstm_scan(q, k, v, log_i, log_f, C0, n0, m0):
    B, H, T, D = q.shape
    nc = T // CHUNK

    def to_chunks(a):
        return jnp.moveaxis(a.reshape(B, H, nc, CHUNK, *a.shape[3:]), 2, 0)

    tril = jnp.tril(jnp.ones((CHUNK, CHUNK), bool))

    def step(carry, xs):
        C, n, m = carry
        qc, kc, vc, ic, fc = xs
        b = jnp.cumsum(fc, axis=-1)
        dmat = jnp.where(tril, b[..., :, None] - b[..., None, :] + ic[..., None, :], -jnp.inf)
        inter = b + m[..., None]
        mt = jnp.maximum(inter, dmat.max(-1))
        A = jnp.exp(dmat - mt[..., None]) * jnp.einsum('bhtd,bhsd->bhts', qc, kc)
        s_in = jnp.exp(inter - mt)
        num = s_in[..., None] * jnp.einsum('bhtd,bhde->bhte', qc, C) + jnp.einsum('bhts,bhse->bhte', A, vc)
        den = s_in * jnp.einsum('bhtd,bhd->bht', qc, n) + A.sum(-1)
        h = num / jnp.maximum(jnp.abs(den), jnp.exp(-mt))[..., None]
        bL = b[..., -1]
        g = bL[..., None] - b + ic
        m_new = jnp.maximum(bL + m, g.max(-1))
        decay = jnp.exp(bL + m - m_new)
        wk = jnp.exp(g - m_new[..., None])[..., None] * kc
        C_new = decay[..., None, None] * C + jnp.einsum('bhsd,bhse->bhde', wk, vc)
        n_new = decay[..., None] * n + wk.sum(-2)
        return (C_new, n_new, m_new), h

    xs = tuple(to_chunks(a) for a in (q, k, v, log_i, log_f))
    (C, n, m), hs = lax.scan(step, (C0, n0, m0), xs)
    h = jnp.moveaxis(hs, 0, 2).reshape(B, H, T, D)
    return h, C, n, m


def rwkv_scan(r, d, k, v, kk, a, S0):
    def step(S, xs):
        rt, dt, kt, vt, kkt, at = xs
        sa = jnp.einsum('bhij,bhj->bhi', S, -kkt)
        S = S * dt[:, :, None, :] + sa[..., :, None] * (kkt * at)[..., None, :] + vt[..., :, None] * kt[..., None, :]
        return S, jnp.einsum('bhij,bhj->bhi', S, rt)

    xs = tuple(jnp.moveaxis(t, 1, 0) for t in (r, d, k, v, kk, a))
    S, ys = lax.scan(step, S0, xs)
    return jnp.moveaxis(ys, 0, 1), S


def mixer(h, st, lw, grid):
    (w_in, m_conv_w, m_conv_b, m_gate_b, m_ln_g, r_mu, r_w0, r_w2, r_a0, r_a2,
     r_k_k, r_k_a, r_r_k, r_ln_g, r_ln_b, w_out) = lw
    C0, n0, m0, S0 = st
    f32 = jnp.float32
    B, T, _ = h.shape
    p = jnp.einsum('btd,dc->btc', h, w_in)
    mq, mk, mv, mo, mz, mg, rz, rs = _split(p, [M_WIDTH] * 5 + [M_GATE_COLS, R_WIDTH, SHIFT_COLS])

    qk = jax.nn.silu(centred_conv(jnp.concatenate([mq, mk], -1), m_conv_w, m_conv_b))
    mq, mk = _split(qk, [M_WIDTH, M_WIDTH])
    heads = lambda a: a.reshape(B, T, M_HEADS, M_DK).transpose(0, 2, 1, 3).astype(f32)
    q = heads(mq)
    k = heads(mk) * (M_DK ** -0.5)
    v = heads(mv)
    gates = (mg.reshape(B, T, N_DIR, 2, M_HEADS).astype(f32) + m_gate_b).transpose(2, 3, 0, 4, 1)
    log_i = gates[:, 0]
    log_f = jax.nn.log_sigmoid(gates[:, 1])
    fl = lambda a: jnp.flip(a, axis=2)
    c32 = lambda a: a.astype(f32)
    h_f, Cf, nf, mf = mlstm_scan(q, k, v, log_i[0], log_f[0], c32(C0[:, 0]), c32(n0[:, 0]), c32(m0[:, 0]))
    h_b, Cb, nb, mb = mlstm_scan(fl(q), fl(k), fl(v), fl(log_i[1]), fl(log_f[1]),
                                 c32(C0[:, 1]), c32(n0[:, 1]), c32(m0[:, 1]))
    hm = jax.nn.sigmoid(heads(mo)) * (h_f + fl(h_b))
    mu = hm.mean(-1, keepdims=True)
    hm = (hm - mu) * lax.rsqrt(jnp.mean((hm - mu) ** 2, axis=-1, keepdims=True) + EPS)
    hm = hm.transpose(0, 2, 1, 3).reshape(B, T, M_WIDTH) * m_ln_g * jax.nn.silu(mz.astype(f32))

    shift = shift_grid if grid else shift_seq
    rs = rs + r_mu * (shift(rs) - rs)
    rr, rk, rv, rwd, rad = _split(rs, [R_WIDTH] * 3 + [N_DIR * LORA, N_DIR * LORA])
    rh = lambda a: a.reshape(B, T, R_HEADS, R_N).astype(f32)
    r = rh(rr)
    vv = rh(rv)
    kraw = rk.astype(f32)
    rwd = rwd.reshape(B, T, N_DIR, LORA).astype(f32)
    rad = rad.reshape(B, T, N_DIR, LORA).astype(f32)
    wlog = -jax.nn.softplus(-(r_w0 + jnp.einsum('btzl,zlc->btzc', jnp.tanh(rwd), r_w2))) - 0.5
    decay = jnp.exp(-jnp.exp(wlog))
    a = jax.nn.sigmoid(r_a0 + jnp.einsum('btzl,zlc->btzc', rad, r_a2))
    kk = rh(kraw * r_k_k)
    kk = kk / jnp.maximum(jnp.sqrt(jnp.sum(kk * kk, axis=-1, keepdims=True)), 1e-12)
    kz = kraw[:, :, None, :] * (1.0 + (a - 1.0) * r_k_a)
    ft = lambda t: jnp.flip(t, axis=1)
    y_f, Sf = rwkv_scan(r, rh(decay[:, :, 0]), rh(kz[:, :, 0]), vv, kk, rh(a[:, :, 0]), c32(S0[:, 0]))
    y_b, Sb = rwkv_scan(ft(r), ft(rh(decay[:, :, 1])), ft(rh(kz[:, :, 1])), ft(vv), ft(kk),
                        ft(rh(a[:, :, 1])), c32(S0[:, 1]))
    y = y_f + ft(y_b)
    ym = y.mean(-1, keepdims=True)
    y = (y - ym) * lax.rsqrt(jnp.mean((y - ym) ** 2, axis=-1, keepdims=True) + LNX_EPS)
    y = y.reshape(B, T, R_WIDTH) * r_ln_g + r_ln_b
    bonus = jnp.einsum('bthn,btzhn,hn->bth', r, kz.reshape(B, T, N_DIR, R_HEADS, R_N), r_r_k)
    y = y + (bonus[..., None] * vv).reshape(B, T, R_WIDTH)
    y = y * jax.nn.silu(rz.astype(f32))

    cat = jnp.concatenate([hm, y], axis=-1).astype(h.dtype)
    out = jnp.einsum('btc,cd->btd', cat, w_out)
    new_st = (jnp.stack([Cf, Cb], 1), jnp.stack([nf, nb], 1), jnp.stack([mf, mb], 1), jnp.stack([Sf, Sb], 1))
    return out, new_st


def block(x, mod, st, lw, norm_g, grid):
    shift, scale, gate = jnp.split(mod, 3, axis=-1)
    h = rmsnorm(x, norm_g) * (1.0 + scale) + shift
    out, new_st = mixer(h, st, lw, grid)
    return x + gate * out, new_st


def setup_inputs(seed: int = 0) -> dict:
    key = jax.random.key(seed)
    ks = jax.random.split(key, 40)
    f32 = jnp.float32
    nrm = lambda k, shape, s: s * jax.random.normal(k, shape, f32)
    L = DEPTH
    return {
        "x_prompt": nrm(ks[0], (BATCH, SEQ, D_MODEL), 1.0),
        "x_sample": nrm(ks[1], (DEC_BATCH, DEC_SEQ, D_MODEL), 1.0),
        "state_mlstm_C": nrm(ks[2], (DEC_BATCH, L, N_DIR, M_HEADS, M_DK, M_DK), 0.05),
        "state_mlstm_n": nrm(ks[3], (DEC_BATCH, L, N_DIR, M_HEADS, M_DK), 0.5),
        "state_mlstm_m": nrm(ks[4], (DEC_BATCH, L, N_DIR, M_HEADS), 1.0),
        "state_rwkv_S": nrm(ks[5], (DEC_BATCH, L, N_DIR, R_HEADS, R_N, R_N), 0.1),
        "c": nrm(ks[6], (DEC_BATCH, D_MODEL), 1.0),
        "c_ctx": nrm(ks[7], (D_MODEL,), 1.0),
        "norm_g": 1.0 + nrm(ks[8], (L, D_MODEL), 0.02),
        "w_ada": nrm(ks[9], (L, D_MODEL, 3 * D_MODEL), 0.5 * D_MODEL ** -0.5),
        "b_ada": nrm(ks[10], (L, 3 * D_MODEL), 0.02),
        "w_in": nrm(ks[11], (L, D_MODEL, IN_COLS), D_MODEL ** -0.5),
        "m_conv_w": nrm(ks[12], (L, CONV_K, 2 * M_WIDTH), CONV_K ** -0.5),
        "m_conv_b": nrm(ks[13], (L, 2 * M_WIDTH), 0.02),
        "m_gate_b": jnp.stack([nrm(ks[14], (L, N_DIR, M_HEADS), 0.1),
                               jnp.linspace(3.0, 6.0, M_HEADS, dtype=f32) + nrm(ks[15], (L, N_DIR, M_HEADS), 0.1)],
                              axis=2),
        "m_ln_g": 1.0 + nrm(ks[16], (L, M_WIDTH), 0.02),
        "r_mu": jax.random.uniform(ks[17], (L, SHIFT_COLS), f32),
        "r_w0": jax.random.uniform(ks[18], (L, N_DIR, R_WIDTH), f32, -6.0, 0.0),
        "r_w2": nrm(ks[19], (L, N_DIR, LORA, R_WIDTH), 0.1 * LORA ** -0.5),
        "r_a0": nrm(ks[20], (L, N_DIR, R_WIDTH), 0.1),
        "r_a2": nrm(ks[21], (L, N_DIR, LORA, R_WIDTH), 0.1 * LORA ** -0.5),
        "r_k_k": 0.85 + nrm(ks[22], (L, R_WIDTH), 0.02),
        "r_k_a": 1.0 + nrm(ks[23], (L, R_WIDTH), 0.02),
        "r_r_k": nrm(ks[24], (L, R_HEADS, R_N), 0.1),
        "r_ln_g": 1.0 + nrm(ks[25], (L, R_WIDTH), 0.02),
        "r_ln_b": nrm(ks[26], (L, R_WIDTH), 0.02),
        "w_out": nrm(ks[27], (L, D_MODEL, D_MODEL), D_MODEL ** -0.5),
        "final_g": 1.0 + nrm(ks[28], (D_MODEL,), 0.02),
    }


def reference(x_prompt, x_sample, state_mlstm_C, state_mlstm_n, state_mlstm_m, state_rwkv_S, c, c_ctx,
              norm_g, w_ada, b_ada, w_in, m_conv_w, m_conv_b, m_gate_b, m_ln_g, r_mu, r_w0, r_w2, r_a0,
              r_a2, r_k_k, r_k_a, r_r_k, r_ln_g, r_ln_b, w_out, final_g):
    f32 = jnp.float32
    bp = x_prompt.shape[0]
    ctx_state0 = (jnp.zeros((bp, N_DIR, M_HEADS, M_DK, M_DK), f32),
                  jnp.zeros((bp, N_DIR, M_HEADS, M_DK), f32),
                  jnp.full((bp, N_DIR, M_HEADS), -jnp.inf, f32),
                  jnp.zeros((bp, N_DIR, R_HEADS, R_N, R_N), f32))
    xp, xs = x_prompt, x_sample
    new_C, new_n, new_m, new_S = [], [], [], []
    for l in range(DEPTH):
        lw = (w_in[l], m_conv_w[l], m_conv_b[l], m_gate_b[l], m_ln_g[l], r_mu[l], r_w0[l], r_w2[l],
              r_a0[l], r_a2[l], r_k_k[l], r_k_a[l], r_r_k[l], r_ln_g[l], r_ln_b[l], w_out[l])
        mod_p = (jax.nn.silu(c_ctx) @ w_ada[l] + b_ada[l])[None, None, :]
        mod_s = (jax.nn.silu(c) @ w_ada[l] + b_ada[l])[:, None, :]
        xp, (Cp, np_, mp, Sp) = block(xp, mod_p, ctx_state0, lw, norm_g[l], False)
        st_s = (state_mlstm_C[:, l], state_mlstm_n[:, l], state_mlstm_m[:, l], state_rwkv_S[:, l])
        xs, _ = block(xs, mod_s, st_s, lw, norm_g[l], True)
        new_C.append(Cp)
        new_n.append(np_)
        new_m.append(mp)
        new_S.append(Sp)
    y_prompt = rmsnorm(xp, final_g)
    y_sample = rmsnorm(xs, final_g)
    return (y_prompt, y_sample, jnp.stack(new_C, 1), jnp.stack(new_n, 1), jnp.stack(new_m, 1), jnp.stack(new_S, 1))
```

```cpp
#include <hip/hip_runtime.h>
#include <hip/hip_cooperative_groups.h>
#include <cstdio>
namespace cg = cooperative_groups;

#ifndef REP
#define REP -1
#endif
#ifndef N_LAUNCHES
#define N_LAUNCHES 1
#endif

typedef unsigned short bf16_t;
typedef short bf16x8 __attribute__((ext_vector_type(8)));
typedef float f32x4 __attribute__((ext_vector_type(4)));
typedef unsigned u32x4 __attribute__((ext_vector_type(4)));
typedef unsigned u32x2 __attribute__((ext_vector_type(2)));

constexpr int DM = 2048, MROWS = 20480, NPROMPT = 4096, TP = 256, TS = 2048;
constexpr int LDP = 9472;
constexpr int NPAD = 9728;
constexpr int C_MQ = 0, C_MK = 1024, C_MV = 2048, C_MO = 3072, C_MZ = 4096, C_RZ = 5120, C_RR = 6144, C_RK = 7168, C_RV = 8192, C_WD = 9216, C_AD = 9344;
constexpr float EPS = 1e-6f, LNX_EPS = 64e-5f;
constexpr int LDS_BYTES = 163840;

constexpr size_t WS_BAR = 0x7C0000, WS_MODP = 0, WS_MOD = 2u << 20, WS_G32 = 3u << 20, WS_BON = 5u << 20, WS_P = 8u << 20;
constexpr size_t WS_WINT = 398458880ull, WS_QKC = WS_WINT  , WS_WOUTT = WS_QKC + (size_t)MROWS * 2048 * 2, WS_XL = WS_WOUTT + (size_t)2048 * 2048 * 2, WS_END = WS_XL + (size_t)MROWS * 256 * 2;
static_assert(WS_END <= 536870912ull, "ws map");
static_assert(WS_P + (size_t)MROWS * LDP * 2 <= WS_WINT, "ws map");
constexpr size_t O_YP = 0, O_YS = 8388608, O_C = 41943040, O_N = 50331648, O_M = 50364416, O_S = 50364544;
constexpr size_t Y_H = 0, Y_HF = 0, Y_HB = 41943040, Y_YF = 83886080, Y_YB = 125829120;

struct Params {
    const float* in[28];
    float* out; unsigned char* ws; int ph_lo, ph_hi, sub, pad;
};
enum { I_XP = 0, I_XS, I_SC, I_SN, I_SM, I_SS, I_C, I_CCTX, I_NORMG, I_WADA, I_BADA, I_WIN, I_CONVW, I_CONVB, I_GATEB, I_MLNG, I_RMU, I_RW0, I_RW2, I_RA0, I_RA2, I_RKK, I_RKA, I_RRK, I_RLNG, I_RLNB, I_WOUT, I_FINALG };

__device__ __forceinline__ float bf2f(unsigned b) { return __uint_as_float(b << 16); }
__device__ __forceinline__ float bflo(unsigned w) { return __uint_as_float(w << 16); }
__device__ __forceinline__ float bfhi(unsigned w) { return __uint_as_float(w & 0xffff0000u); }
__device__ __forceinline__ unsigned pk2(float lo, float hi) { unsigned r; asm("v_cvt_pk_bf16_f32 %0, %1, %2" : "=v"(r) : "v"(lo), "v"(hi)); return r; }
__device__ __forceinline__ unsigned f2bf(float f) { unsigned u = __float_as_uint(f); return (u + 0x7fffu + ((u >> 16) & 1u)) >> 16; }
__device__ __forceinline__ float opaque_zero() { float z; asm volatile("v_mov_b32 %0, 0" : "=v"(z)); return z; }
__device__ __forceinline__ unsigned pk2_sw(float lo, float hi) { return f2bf(lo) | (f2bf(hi) << 16); }
__device__ __forceinline__ float sigmoid_f(float x) { return 1.f / (1.f + __expf(-x)); }
__device__ __forceinline__ float silu_f(float x) { return x / (1.f + __expf(-x)); }
__device__ __forceinline__ float softplus_f(float y) { return fmaxf(y, 0.f) + log1pf(__expf(-fabsf(y))); }
__device__ __forceinline__ float wave_sum(float v) {
#pragma unroll
    for (int o = 1; o < 64; o <<= 1) v += __shfl_xor(v, o);
    return v;
}
__device__ __forceinline__ float dpp_f(float v, const int ctrl_sel) {
    int i = __float_as_int(v), r;
    if (ctrl_sel == 0) r = __builtin_amdgcn_update_dpp(0, i, 0xB1, 0xF, 0xF, true);
    else if (ctrl_sel == 1) r = __builtin_amdgcn_update_dpp(0, i, 0x4E, 0xF, 0xF, true);
    else r = __builtin_amdgcn_update_dpp(0, i, 0x141, 0xF, 0xF, true);
    return __int_as_float(r);
}
__device__ __forceinline__ float red8(float v) { v += dpp_f(v, 0); v += dpp_f(v, 1); v += dpp_f(v, 2); return v; }
__device__ __forceinline__ float red4(float v) { v += dpp_f(v, 0); v += dpp_f(v, 1); return v; }

__device__ __forceinline__ float dpp_id(float ident, float v, const int sel) {
    const int o = __float_as_int(ident), i = __float_as_int(v); int r;
    if (sel == 0) r = __builtin_amdgcn_update_dpp(o, i, 0x111, 0xF, 0xF, false);
    else if (sel == 1) r = __builtin_amdgcn_update_dpp(o, i, 0x112, 0xF, 0xF, false);
    else if (sel == 2) r = __builtin_amdgcn_update_dpp(o, i, 0x114, 0xF, 0xF, false);
    else if (sel == 3) r = __builtin_amdgcn_update_dpp(o, i, 0x118, 0xF, 0xF, false);
    else if (sel == 4) r = __builtin_amdgcn_update_dpp(o, i, 0x142, 0xA, 0xF, false);
    else r = __builtin_amdgcn_update_dpp(o, i, 0x143, 0xC, 0xF, false);
    return __int_as_float(r);
}
__device__ __forceinline__ float wave_scan_add(float v) {
    v += dpp_id(0.f, v, 0); v += dpp_id(0.f, v, 1); v += dpp_id(0.f, v, 2); v += dpp_id(0.f, v, 3); v += dpp_id(0.f, v, 4); v += dpp_id(0.f, v, 5); return v;
}
__device__ __forceinline__ float wave_scan_max(float v) {
    const float ni = -INFINITY;
    v = fmaxf(v, dpp_id(ni, v, 0)); v = fmaxf(v, dpp_id(ni, v, 1)); v = fmaxf(v, dpp_id(ni, v, 2)); v = fmaxf(v, dpp_id(ni, v, 3)); v = fmaxf(v, dpp_id(ni, v, 4)); v = fmaxf(v, dpp_id(ni, v, 5)); return v;
}
__device__ __forceinline__ float lane63(float v) { return __int_as_float(__builtin_amdgcn_readlane(__float_as_int(v), 63)); }
__device__ __forceinline__ int row_rid(int row) { return row < NPROMPT ? 0 : 1 + ((row - NPROMPT) >> 11); }
__device__ __forceinline__ void nbrs(int row, int& n0, int& n1, int& n2, int& n3, bool& k0, bool& k1, bool& k2, bool& k3) {
    if (row < NPROMPT) { const int t = row & 255; n0 = n2 = row - 1; k0 = k2 = t > 0; n1 = n3 = row + 1; k1 = k3 = t < 255; }
    else { const int t = (row - NPROMPT) & 2047, cc = t & 63, gr = t >> 6;
        n0 = row - 1; k0 = cc > 0; n1 = row + 1; k1 = cc < 63; n2 = row - 64; k2 = gr > 0; n3 = row + 64; k3 = gr < 31; }
}

namespace pg8 {
#define PG8_LAS __attribute__((address_space(3)))
constexpr int BM = 256, BK = 64, HALF = 128, HTB = HALF * BK * 2, STAGE_BYTES = 8 * HTB, NXCD = 8, WGM = 8;
__host__ __device__ __forceinline__ int lds_byte(int r, int c) { const int st = (r >> 4) * 2 + (c >> 5), rr = r & 15, cc = c & 31, ob = rr * 64 + cc * 2; return st * 1024 + (ob ^ (((ob >> 9) & 1) << 5)); }
__host__ __device__ __forceinline__ void stage_rc(int b, int& R, int& C) { const int st = b / 1024, sb = b % 1024, swz = sb ^ (((sb >> 9) & 1) << 5); R = (st >> 1) * 16 + swz / 64; C = (st & 1) * 32 + (swz % 64) / 2; }
__host__ __device__ __forceinline__ int perm32(int rho) { const int n = rho >> 4, i = rho & 15; return 8 * (i >> 2) + 4 * n + (i & 3); }
struct Unit { int pm, pn; };
struct Gemm { const bf16_t* A; const bf16_t* Bt; int M, N, K, lda; };
struct StaticOrder {
    int nM, nN, nwg, G, c;
    __host__ __device__ void init(int M, int N, int G_, int c_) { nM = M / BM; nN = N / BM; nwg = nM * nN; G = G_; c = c_; }
    __host__ __device__ bool next(int i, Unit& u) const {
        const long L = (long)i * G + c; if (L >= nwg) return false;
        int wgid = (int)L; { const int q = nwg / NXCD, r = nwg % NXCD, xcd = wgid % NXCD, off = wgid / NXCD; wgid = (xcd < r ? xcd * (q + 1) : r * (q + 1) + (xcd - r) * q) + off; }
        const int nig = WGM * nN, gid = wgid / nig, fm = gid * WGM, gsz = (nM - fm) < WGM ? (nM - fm) : WGM;
        u.pm = fm + ((wgid % nig) % gsz); u.pn = (wgid % nig) / gsz; return true;
    }
};
__device__ __forceinline__ unsigned cvt_pk_bf16(float lo, float hi) { unsigned r; asm volatile("v_cvt_pk_bf16_f32 %0, %1, %2" : "=v"(r) : "v"(lo), "v"(hi)); return r; }

template <class Epi>
__device__ __forceinline__ void gemm_phase(PG8_LAS unsigned char* lds, const Gemm g, const StaticOrder& S, const Epi& E) {
    const int tid = threadIdx.x, wid = __builtin_amdgcn_readfirstlane(tid >> 6), lane = tid & 63, wr = wid >> 2, wc = wid & 3, fr = lane & 15, fq = lane >> 4;
    const int K = g.K, nt = K / BK, lda = g.lda;
    unsigned voffA[2], voffB[2];
#pragma unroll
    for (int i = 0; i < 2; ++i) { int R, C; stage_rc(tid * 16 + i * 8192, R, C); const int Rb = Epi::PERM ? ((R & ~31) + perm32(R & 31)) : R;
        voffA[i] = (unsigned)(R * lda + C) * 2u; voffB[i] = (unsigned)(Rb * K + C) * 2u; }
    const size_t kstep = (size_t)(BK * 2);
    const size_t hstepA = (size_t)HALF * lda * 2, hstepB = (size_t)HALF * K * 2;
    const size_t tstepA = 2 * hstepA, tstepB = 2 * hstepB;
    const unsigned ldsw = (unsigned)wid * 1024u;
    const int aoff = lds_byte(wr * 64 + fr, fq * 8), boff = lds_byte(wc * 32 + fr, fq * 8);
#define PG8_SA(b, h) (((b) * 2 + (h)) * HTB)
#define PG8_SB(b, h) ((4 + (b) * 2 + (h)) * HTB)
#define PG8_STAGE(bufoff, gbase, voff) do { _Pragma("unroll") for (int _i = 0; _i < 2; ++_i) \
        __builtin_amdgcn_global_load_lds((const unsigned*)((const char*)(gbase) + (voff)[_i]), (PG8_LAS unsigned*)(lds + (bufoff) + ldsw + _i * 8192), 16, 0, 0); } while (0)
#define PG8_LDA(dst, b, h) do { _Pragma("unroll") for (int m = 0; m < 4; ++m) _Pragma("unroll") for (int k = 0; k < 2; ++k) dst[m][k] = *(const PG8_LAS bf16x8*)(lds + PG8_SA(b, h) + aoff + m * 2048 + k * 1024); } while (0)
#define PG8_LDB(dst, b, h) do { _Pragma("unroll") for (int n = 0; n < 2; ++n) _Pragma("unroll") for (int k = 0; k < 2; ++k) dst[n][k] = *(const PG8_LAS bf16x8*)(lds + PG8_SB(b, h) + boff + n * 2048 + k * 1024); } while (0)
#define PG8_MMA(ai, bj, At, Bt) do { __builtin_amdgcn_s_setprio(1); _Pragma("unroll") for (int m = 0; m < 4; ++m) _Pragma("unroll") for (int n = 0; n < 2; ++n) _Pragma("unroll") for (int k = 0; k < 2; ++k) \
        acc[ai][bj][m][n] = __builtin_amdgcn_mfma_f32_16x16x32_bf16(Bt[n][k], At[m][k], acc[ai][bj][m][n], 0, 0, 0); __builtin_amdgcn_s_setprio(0); } while (0)
#define PG8_WAIT_V(n) asm volatile("s_waitcnt vmcnt(" #n ")" ::: "memory")
#define PG8_WAIT_L(n) asm volatile("s_waitcnt lgkmcnt(" #n ")" ::: "memory")
#define PG8_BAR __builtin_amdgcn_s_barrier()
#define PG8_SCHED __builtin_amdgcn_sched_barrier(0)
    Unit cur, nxt; int ui = 0;
    if (!S.next(0, cur)) return;
    f32x4 acc[2][2][4][2];
#pragma unroll
    for (int a = 0; a < 2; ++a)
#pragma unroll
        for (int b = 0; b < 2; ++b)
#pragma unroll
            for (int m = 0; m < 4; ++m)
#pragma unroll
                for (int n = 0; n < 2; ++n) acc[a][b][m][n] = (f32x4){0.f, 0.f, 0.f, 0.f};
    bf16x8 At[4][2], B0[2][2], B1[2][2];
    const char* cA = (const char*)g.A + (size_t)cur.pm * tstepA; const char* cB = (const char*)g.Bt + (size_t)cur.pn * tstepB;
    PG8_STAGE(PG8_SB(0, 0), cB, voffB); PG8_STAGE(PG8_SA(0, 0), cA, voffA); PG8_STAGE(PG8_SB(0, 1), cB + hstepB, voffB); PG8_STAGE(PG8_SA(0, 1), cA + hstepA, voffA);
    if (wr == 1) PG8_BAR;
    PG8_WAIT_V(4); PG8_BAR;
    PG8_STAGE(PG8_SB(1, 0), cB + kstep, voffB); PG8_STAGE(PG8_SA(1, 0), cA + kstep, voffA); PG8_STAGE(PG8_SB(1, 1), cB + hstepB + kstep, voffB);
    PG8_WAIT_V(6); PG8_BAR;
    for (;;) {
        const bool has_next = S.next(ui + 1, nxt);
        const char* nA = has_next ? (const char*)g.A + (size_t)nxt.pm * tstepA : cA; const char* nB = has_next ? (const char*)g.Bt + (size_t)nxt.pn * tstepB : cB;
        for (int t = 0; t < nt; t += 2) {
            const bool last = (t == nt - 2);
            const char* a1 = cA + (size_t)(t + 1) * kstep;
            const char* a2 = last ? nA : cA + (size_t)(t + 2) * kstep; const char* b2 = last ? nB : cB + (size_t)(t + 2) * kstep;
            const char* a3 = a2 + kstep; const char* b3 = b2 + kstep;
            PG8_LDB(B0, 0, 0); PG8_SCHED; PG8_LDA(At, 0, 0); PG8_STAGE(PG8_SA(1, 1), a1 + hstepA, voffA);
            PG8_WAIT_L(8); PG8_BAR; PG8_WAIT_L(0); PG8_MMA(0, 0, At, B0); PG8_BAR; PG8_SCHED;
            PG8_LDB(B1, 0, 1); PG8_STAGE(PG8_SB(0, 0), b2, voffB);
            PG8_BAR; PG8_WAIT_L(0); PG8_MMA(0, 1, At, B1); PG8_BAR;
            PG8_LDA(At, 0, 1); PG8_STAGE(PG8_SA(0, 0), a2, voffA);
            PG8_BAR; PG8_WAIT_L(0); PG8_MMA(1, 0, At, B0); PG8_BAR; PG8_SCHED;
            PG8_STAGE(PG8_SB(0, 1), b2 + hstepB, voffB);
            PG8_WAIT_V(6); PG8_BAR; PG8_MMA(1, 1, At, B1); PG8_BAR;
            PG8_LDB(B0, 1, 0); PG8_SCHED; PG8_LDA(At, 1, 0); PG8_STAGE(PG8_SA(0, 1), a2 + hstepA, voffA);
            PG8_WAIT_L(8); PG8_BAR; PG8_WAIT_L(0); PG8_MMA(0, 0, At, B0); PG8_BAR; PG8_SCHED;
            PG8_LDB(B1, 1, 1); PG8_STAGE(PG8_SB(1, 0), b3, voffB);
            PG8_BAR; PG8_WAIT_L(0); PG8_MMA(0, 1, At, B1); PG8_BAR;
            PG8_LDA(At, 1, 1); PG8_STAGE(PG8_SA(1, 0), a3, voffA);
            PG8_BAR; PG8_WAIT_L(0); PG8_MMA(1, 0, At, B0); PG8_BAR; PG8_SCHED;
            PG8_STAGE(PG8_SB(1, 1), b3 + hstepB, voffB);
            PG8_WAIT_V(6); PG8_BAR; PG8_MMA(1, 1, At, B1); PG8_BAR;
        }
        E(acc, cur, wr, wc, fr, fq);
        if (!has_next) break;
#pragma unroll
        for (int a = 0; a < 2; ++a)
#pragma unroll
            for (int b = 0; b < 2; ++b)
#pragma unroll
                for (int m = 0; m < 4; ++m)
#pragma unroll
                    for (int n = 0; n < 2; ++n) acc[a][b][m][n] = (f32x4){0.f, 0.f, 0.f, 0.f};
        cur = nxt; cA = nA; cB = nB; ++ui;
    }
    PG8_WAIT_V(0);
    if (wr == 0) PG8_BAR;
    PG8_BAR;
#undef PG8_SA
#undef PG8_SB
#undef PG8_STAGE
#undef PG8_LDA
#undef PG8_LDB
#undef PG8_MMA
#undef PG8_WAIT_V
#undef PG8_WAIT_L
#undef PG8_BAR
#undef PG8_SCHED
}

struct EpiP {
    static constexpr bool PERM = true;
    bf16_t* P; float* G32;
    __device__ __forceinline__ void operator()(const f32x4 (&acc)[2][2][4][2], const Unit& u, int wr, int wc, int fr, int fq) const {
        const int row0 = u.pm * BM + wr * 64 + fr;
        if (u.pn < 37) {
            const int col0 = u.pn * BM + wc * 32 + 8 * fq;
#pragma unroll
            for (int ai = 0; ai < 2; ++ai)
#pragma unroll
                for (int m = 0; m < 4; ++m) { bf16_t* rowp = P + (size_t)(row0 + ai * HALF + m * 16) * LDP + col0;
#pragma unroll
                    for (int bj = 0; bj < 2; ++bj) { const f32x4 v0 = acc[ai][bj][m][0], v1 = acc[ai][bj][m][1];
                        u32x4 w; w.x = cvt_pk_bf16(v0[0], v0[1]); w.y = cvt_pk_bf16(v0[2], v0[3]); w.z = cvt_pk_bf16(v1[0], v1[1]); w.w = cvt_pk_bf16(v1[2], v1[3]);
                        *(u32x4*)(rowp + bj * HALF) = w; } }
        } else if (wc == 0 && fq < 2) {
#pragma unroll
            for (int ai = 0; ai < 2; ++ai)
#pragma unroll
                for (int m = 0; m < 4; ++m) { float* rowp = G32 + (size_t)(row0 + ai * HALF + m * 16) * 16 + 8 * fq;
                    *(f32x4*)(rowp) = acc[ai][0][m][0]; *(f32x4*)(rowp + 4) = acc[ai][0][m][1]; }
        }
    }
};
struct EpiRes {
    static constexpr bool PERM = true;
    const float* xp; const float* xs; const float* MOD; bf16_t* XN;
    __device__ __forceinline__ void operator()(const f32x4 (&acc)[2][2][4][2], const Unit& u, int wr, int wc, int fr, int fq) const {
        const int col0 = u.pn * BM + wc * 32 + 8 * fq;
        const int rid = row_rid(u.pm * BM);
        const float* x = (u.pm < 16) ? xp + (size_t)(u.pm * BM) * DM : xs + (size_t)(u.pm * BM - NPROMPT) * DM;
        f32x4 gv[2][2];
#pragma unroll
        for (int bj = 0; bj < 2; ++bj)
#pragma unroll
            for (int n = 0; n < 2; ++n) gv[bj][n] = *(const f32x4*)(MOD + (size_t)rid * 6144 + 4096 + col0 + bj * HALF + 4 * n);
        const float* xb = x + (size_t)(wr * 64 + fr) * DM + col0;
        bf16_t* ob = XN + (size_t)(u.pm * BM + wr * 64 + fr) * DM + col0;
#pragma unroll
        for (int ai = 0; ai < 2; ++ai)
#pragma unroll
            for (int mp = 0; mp < 2; ++mp) {
                f32x4 xv[2][2][2];
#pragma unroll
                for (int mm = 0; mm < 2; ++mm)
#pragma unroll
                    for (int bj = 0; bj < 2; ++bj)
#pragma unroll
                        for (int n = 0; n < 2; ++n) xv[mm][bj][n] = __builtin_nontemporal_load((const f32x4*)(xb + (size_t)(ai * HALF + (mp * 2 + mm) * 16) * DM + bj * HALF + 4 * n));
                asm volatile("" ::: "memory");
#pragma unroll
                for (int mm = 0; mm < 2; ++mm)
#pragma unroll
                    for (int bj = 0; bj < 2; ++bj) {
                        const f32x4 v0 = xv[mm][bj][0] + gv[bj][0] * acc[ai][bj][mp * 2 + mm][0], v1 = xv[mm][bj][1] + gv[bj][1] * acc[ai][bj][mp * 2 + mm][1];
                        u32x4 w; w.x = pk2(v0[0], v0[1]); w.y = pk2(v0[2], v0[3]); w.z = pk2(v1[0], v1[1]); w.w = pk2(v1[2], v1[3]);
                        *(u32x4*)(ob + (size_t)(ai * HALF + (mp * 2 + mm) * 16) * DM + bj * HALF) = w;
                    }
                asm volatile("" ::: "memory");
            }
    }
};
}

__device__ __forceinline__ void transpose_item(const float* W, int ldw, int srccol, bf16_t* WT, int K, int dst_n0, int k0, float* scr, int lane) {
    float tv[32];
#pragma unroll
    for (int i = 0; i < 32; ++i) { const int kk = 2 * i + (lane >> 5); tv[i] = srccol >= 0 ? __builtin_nontemporal_load(W + (size_t)(k0 + kk) * ldw + srccol) : 0.f; }
#pragma unroll
    for (int i = 0; i < 32; ++i) { const int kk = 2 * i + (lane >> 5); scr[kk * 33 + (lane & 31)] = tv[i]; }
    asm volatile("s_waitcnt lgkmcnt(0)" ::: "memory");
    const int c = lane & 7;
#pragma unroll
    for (int j = 0; j < 4; ++j) { const int n = (lane >> 3) + 8 * j; const float* s = scr + (8 * c) * 33 + n;
        u32x4 o; o.x = pk2(s[0 * 33], s[1 * 33]); o.y = pk2(s[2 * 33], s[3 * 33]); o.z = pk2(s[4 * 33], s[5 * 33]); o.w = pk2(s[6 * 33], s[7 * 33]);
        *(u32x4*)(WT + (size_t)(dst_n0 + n) * K + k0 + 8 * c) = o; }
    asm volatile("s_waitcnt lgkmcnt(0)" ::: "memory");
}
__device__ __forceinline__ void phase0(const Params& p, unsigned char* lds) {
    const int tid = threadIdx.x, lane = tid & 63, wave = __builtin_amdgcn_readfirstlane(tid >> 6);
    float* sc = (float*)lds;
    float* scr = (float*)(lds + 73728) + wave * (64 * 33);
    for (int i = tid; i < 9 * 2048; i += 512) { const int r = i >> 11, k = i & 2047; const float v = r == 0 ? p.in[I_CCTX][k] : p.in[I_C][(r - 1) * 2048 + k]; sc[i] = silu_f(v); }
    __syncthreads();
    const int gw = blockIdx.x * 8 + wave, NGW = gridDim.x * 8;
    constexpr int I_GV = 192 * 8, I_IN = 32 * 297, I_OUT = 32 * 64;
    bf16_t* WinT = (bf16_t*)(p.ws + WS_WINT); bf16_t* WoutT = (bf16_t*)(p.ws + WS_WOUTT); float* MODP = (float*)(p.ws + WS_MODP);
    for (int it = gw; it < I_GV + I_IN + I_OUT; it += NGW) {
        if (it < I_GV) {
            const int ng = it % 192, kb = it / 192, col = ng * 32 + (lane & 31), kh = lane >> 5;
            float acc[9];
#pragma unroll
            for (int r = 0; r < 9; ++r) acc[r] = 0.f;
            const float* wp = p.in[I_WADA] + (size_t)(kb * 256 + kh) * 6144 + col;
#pragma unroll 16
            for (int i = 0; i < 128; ++i) { const float w = __builtin_nontemporal_load(wp + (size_t)(2 * i) * 6144); const int k = kb * 256 + 2 * i + kh;
#pragma unroll
                for (int r = 0; r < 9; ++r) acc[r] += sc[r * 2048 + k] * w; }
#pragma unroll
            for (int r = 0; r < 9; ++r) { acc[r] += __shfl_xor(acc[r], 32); if (lane < 32) MODP[(size_t)(kb * 9 + r) * 6144 + col] = acc[r]; }
        } else if (it < I_GV + I_IN) {
            const int j = it - I_GV, kb = j / 297, ng = j % 297, n = ng * 32 + (lane & 31);
            const int src = n < 5120 ? n : (n < 9472 ? n + 16 : (n < 9488 ? n - 9472 + 5120 : -1));
            transpose_item(p.in[I_WIN], 9488, src, WinT, 2048, ng * 32, kb * 64, scr, lane);
        } else {
            const int j = it - I_GV - I_IN, kb = j / 64, ng = j % 64;
            transpose_item(p.in[I_WOUT], 2048, ng * 32 + (lane & 31), WoutT, 2048, ng * 32, kb * 64, scr, lane);
        }
    }
}

__device__ __forceinline__ void phase1(const Params& p, unsigned char* lds) {
    const int tid = threadIdx.x, lane = tid & 63, wave = __builtin_amdgcn_readfirstlane(tid >> 6);
    const float* MODP = (const float*)(p.ws + WS_MODP); float* MOD = (float*)(p.ws + WS_MOD);
    const float* b_ada = p.in[I_BADA];
    for (int i = blockIdx.x * 512 + tid; i < 9 * 6144; i += gridDim.x * 512) { const int n = i % 6144; float s = b_ada[n];
#pragma unroll
        for (int kb = 0; kb < 8; ++kb) s += MODP[(size_t)kb * 9 * 6144 + i];
        MOD[i] = s; }
    float* A = (float*)lds; float* B = A + 4096;
    const int rpb = MROWS / gridDim.x, rowbase = blockIdx.x * rpb;
    const int r_lo = row_rid(rowbase), r_hi = row_rid(rowbase + rpb - 1);
    for (int idx = tid; idx < 4096; idx += 512) { const int which = idx >> 11, n = idx & 2047, r = which ? r_hi : r_lo;
        float sh = b_ada[n], scl = b_ada[2048 + n];
#pragma unroll
        for (int kb = 0; kb < 8; ++kb) { sh += MODP[(size_t)(kb * 9 + r) * 6144 + n]; scl += MODP[(size_t)(kb * 9 + r) * 6144 + 2048 + n]; }
        A[idx] = p.in[I_NORMG][n] * (1.f + scl); B[idx] = sh; }
    __syncthreads();
    bf16_t* H = (bf16_t*)((unsigned char*)p.out + Y_H);
    for (int row = rowbase + wave; row < rowbase + rpb; row += 8) {
        const float* x = row < NPROMPT ? p.in[I_XP] + (size_t)row * DM : p.in[I_XS] + (size_t)(row - NPROMPT) * DM;
        const int sel = (row_rid(row) == r_lo) ? 0 : 2048;
        f32x4 v[8]; float ss = 0.f;
#pragma unroll
        for (int j = 0; j < 8; ++j) { v[j] = __builtin_nontemporal_load((const f32x4*)(x + 4 * lane + 256 * j)); ss += (v[j].x * v[j].x + v[j].y * v[j].y) + (v[j].z * v[j].z + v[j].w * v[j].w); }
        const float rstd = rsqrtf(wave_sum(ss) * (1.f / DM) + EPS);
#pragma unroll
        for (int j = 0; j < 8; ++j) { const int c = 4 * lane + 256 * j; const f32x4 a = *(const f32x4*)(A + sel + c), b = *(const f32x4*)(B + sel + c);
            u32x2 o; o.x = pk2(v[j].x * rstd * a.x + b.x, v[j].y * rstd * a.y + b.y); o.y = pk2(v[j].z * rstd * a.z + b.z, v[j].w * rstd * a.w + b.w);
            *(u32x2*)(H + (size_t)row * DM + c) = o; }
    }
}

__device__ __forceinline__ float shift_mix(float x, float sh, float mu) { return x + mu * (sh - x); }
__device__ __forceinline__ float fast_tanh(float x) { return 1.f - 2.f * __builtin_amdgcn_rcpf(1.f + __expf(2.f * x)); }
__device__ __forceinline__ void phase_prep(const Params& p) {
    const int tid = threadIdx.x, lane = tid & 63, wave = __builtin_amdgcn_readfirstlane(tid >> 6);
    const bf16_t* P = (const bf16_t*)(p.ws + WS_P);
    bf16_t* QKC = (bf16_t*)(p.ws + WS_QKC); bf16_t* XL = (bf16_t*)(p.ws + WS_XL);
    const float* cw = p.in[I_CONVW]; const float* cb = p.in[I_CONVB];
    {
        const int o8 = (tid & 255) * 8, half = tid >> 8, rpb = MROWS / gridDim.x, rbeg = blockIdx.x * rpb + half * (rpb / 2), rend = rbeg + rpb / 2;
        const f32x4 w0a = *(const f32x4*)(cw + o8), w0b = *(const f32x4*)(cw + o8 + 4), w1a = *(const f32x4*)(cw + 2048 + o8), w1b = *(const f32x4*)(cw + 2052 + o8), w2a = *(const f32x4*)(cw + 4096 + o8), w2b = *(const f32x4*)(cw + 4100 + o8);
        const f32x4 ba = *(const f32x4*)(cb + o8), bb = *(const f32x4*)(cb + o8 + 4);
        const float sc = o8 >= 1024 ? 0.0625f : 1.f;
        const u32x4 zero = (u32x4){0u, 0u, 0u, 0u};
        u32x4 xm = rbeg > 0 ? *(const u32x4*)(P + (size_t)(rbeg - 1) * LDP + o8) : zero;
        u32x4 xc = *(const u32x4*)(P + (size_t)rbeg * LDP + o8);
#pragma unroll 1
        for (int rb = rbeg; rb < rend; rb += 8) {
            u32x4 xb[8];
#pragma unroll
            for (int i = 0; i < 8; ++i) xb[i] = (rb + i + 1 < MROWS) ? __builtin_nontemporal_load((const u32x4*)(P + (size_t)(rb + i + 1) * LDP + o8)) : zero;
#pragma unroll
            for (int i = 0; i < 8; ++i) {
                const int row = rb + i; const u32x4 xn = xb[i];
                const int T = row < NPROMPT ? TP : TS, tk = row < NPROMPT ? (row & 255) : ((row - NPROMPT) & 2047);
                const u32x4 x0 = tk > 0 ? xm : zero, x1 = xc, x2 = tk < T - 1 ? xn : zero;
                float o[8];
                o[0] = ba.x + w0a.x * bflo(x0.x) + w1a.x * bflo(x1.x) + w2a.x * bflo(x2.x);
                o[1] = ba.y + w0a.y * bfhi(x0.x) + w1a.y * bfhi(x1.x) + w2a.y * bfhi(x2.x);
                o[2] = ba.z + w0a.z * bflo(x0.y) + w1a.z * bflo(x1.y) + w2a.z * bflo(x2.y);
                o[3] = ba.w + w0a.w * bfhi(x0.y) + w1a.w * bfhi(x1.y) + w2a.w * bfhi(x2.y);
                o[4] = bb.x + w0b.x * bflo(x0.z) + w1b.x * bflo(x1.z) + w2b.x * bflo(x2.z);
                o[5] = bb.y + w0b.y * bfhi(x0.z) + w1b.y * bfhi(x1.z) + w2b.y * bfhi(x2.z);
                o[6] = bb.z + w0b.z * bflo(x0.w) + w1b.z * bflo(x1.w) + w2b.z * bflo(x2.w);
                o[7] = bb.w + w0b.w * bfhi(x0.w) + w1b.w * bfhi(x1.w) + w2b.w * bfhi(x2.w);
#pragma unroll
                for (int e = 0; e < 8; ++e) o[e] = silu_f(o[e]) * sc;
                u32x4 ov; ov.x = pk2(o[0], o[1]); ov.y = pk2(o[2], o[3]); ov.z = pk2(o[4], o[5]); ov.w = pk2(o[6], o[7]);
                *(u32x4*)(QKC + (size_t)row * 2048 + o8) = ov;
                xm = xc; xc = xn;
            }
        }
    }
    for (int row = blockIdx.x * 8 + wave; row < MROWS; row += gridDim.x * 8) {
        const bf16_t* prow = P + (size_t)row * LDP;
        {
            int n0, n1, n2, n3; bool k0, k1, k2, k3; nbrs(row, n0, n1, n2, n3, k0, k1, k2, k3);
            const int cl = 4 * lane; const u32x2 z2 = (u32x2){0u, 0u};
            const u32x2 own = *(const u32x2*)(prow + C_WD + cl);
            const u32x2 v0 = k0 ? *(const u32x2*)(P + (size_t)n0 * LDP + C_WD + cl) : z2, v1 = k1 ? *(const u32x2*)(P + (size_t)n1 * LDP + C_WD + cl) : z2;
            const u32x2 v2 = k2 ? *(const u32x2*)(P + (size_t)n2 * LDP + C_WD + cl) : z2, v3 = k3 ? *(const u32x2*)(P + (size_t)n3 * LDP + C_WD + cl) : z2;
            const f32x4 mu = *(const f32x4*)(p.in[I_RMU] + 3072 + cl);
            float a = bflo(own.x), b = bfhi(own.x), c = bflo(own.y), d = bfhi(own.y);
            a += mu.x * (bflo(v0.x) - a); b += mu.y * (bfhi(v1.x) - b); c += mu.z * (bflo(v2.y) - c); d += mu.w * (bfhi(v3.y) - d);
            if (lane < 32) { a = fast_tanh(a); b = fast_tanh(b); c = fast_tanh(c); d = fast_tanh(d); }
            u32x2 o; o.x = pk2(a, b); o.y = pk2(c, d);
            *(u32x2*)(XL + (size_t)row * 256 + cl) = o;
        }
    }
}

constexpr int RCH = 32;
typedef float f32x2 __attribute__((ext_vector_type(2)));
__device__ __forceinline__ float dpp_rowmirror(float v) { return __int_as_float(__builtin_amdgcn_update_dpp(0, __float_as_int(v), 0x140, 0xF, 0xF, true)); }
__device__ __forceinline__ float red16(float v) { v += dpp_f(v, 0); v += dpp_f(v, 1); v += dpp_f(v, 2); v += dpp_rowmirror(v); return v; }
struct RwkvRaw { u32x4 xl[2][2]; u32x2 own[3], nb[4][3]; };
template <int KS> __device__ __forceinline__ f32x4 tile_mm(const bf16_t* A, int pa, const bf16_t* B, int pb, int fr, int kg, f32x4 acc) {
#pragma unroll
    for (int kk = 0; kk < KS; ++kk) {
        const bf16x8 a = *(const bf16x8*)(A + fr * pa + kk * 32 + kg * 8), b = *(const bf16x8*)(B + fr * pb + kk * 32 + kg * 8);
        acc = __builtin_amdgcn_mfma_f32_16x16x32_bf16(a, b, acc, 0, 0, 0);
    }
    return acc;
}
__device__ __forceinline__ void store_nat(bf16_t* Z, int pz, int n0, int m0, int fr, int kg, f32x4 v, float zv) {
    v = v + zv;
    u32x2 o; o.x = pk2(v[0], v[1]); o.y = pk2(v[2], v[3]); *(u32x2*)(Z + (n0 + fr) * pz + m0 + kg * 4) = o;
}
constexpr int VP = 72, TP40 = 40;
__device__ void rwkv_chain(const Params& p, unsigned char* lds, int row0, int T, int z, int hd, const float* S0, float* Sout) {
    const int tid = threadIdx.x, lane = tid & 63, wave = __builtin_amdgcn_readfirstlane(tid >> 6);
    const bf16_t* P = (const bf16_t*)(p.ws + WS_P);
    const bf16_t* XL = (const bf16_t*)(p.ws + WS_XL);
    float* LW = (float*)lds;
    float* AA = LW + 2048;
    float* DL = AA + 2048;
    float* DEND = DL + 2048;
    bf16_t* ALb = (bf16_t*)(DEND + 64);
    bf16_t* RHb = ALb + 32 * VP;
    bf16_t* BEb = RHb + 32 * VP;
    bf16_t* KAb = BEb + 32 * VP;
    bf16_t* BET = KAb + 32 * VP;
    bf16_t* KAT = BET + 64 * TP40;
    bf16_t* VVT = KAT + 64 * TP40;
    bf16_t* Sb = VVT + 64 * TP40;
    bf16_t* NDg = Sb + 64 * VP;
    bf16_t* NDt = NDg + 4 * 16 * TP40;
    bf16_t* HD = NDt + 4 * 16 * TP40;
    bf16_t* N12T = HD + 4 * 16 * TP40;
    bf16_t* HH = N12T + 16 * TP40;
    bf16_t* TKT = HH + 32 * TP40;
    bf16_t* PBT = TKT + 32 * TP40;
    bf16_t* PKT = PBT + 32 * TP40;
    bf16_t* Wb = PKT + 32 * TP40;
    bf16_t* Ub = Wb + 64 * TP40;
    const float zv = opaque_zero();
    bf16_t* Yout = (bf16_t*)((unsigned char*)p.out + (z ? Y_YB : Y_YF));
    float* BON = (float*)(p.ws + WS_BON) + (size_t)z * MROWS * 16;
    const int type = wave >> 2, tile = wave & 3, fr = lane & 15, kg = lane >> 4;
    bf16x8 Bfrag[2];
    {
        const float* W2 = (type ? p.in[I_RA2] : p.in[I_RW2]) + (size_t)z * 64 * 1024 + hd * 64 + tile * 16 + fr;
#pragma unroll
        for (int kk = 0; kk < 2; ++kk) {
            float w[8];
#pragma unroll
            for (int j = 0; j < 8; ++j) w[j] = W2[(size_t)(kk * 32 + kg * 8 + j) * 1024];
            u32x4 t; t.x = pk2(w[0], w[1]); t.y = pk2(w[2], w[3]); t.z = pk2(w[4], w[5]); t.w = pk2(w[6], w[7]);
            Bfrag[kk] = __builtin_bit_cast(bf16x8, t);
        }
    }
    const int ccA = tile * 16 + fr;
    const float biasA = type ? p.in[I_RA0][z * 1024 + hd * 64 + ccA] : p.in[I_RW0][z * 1024 + hd * 64 + ccA];
    const int pB = tid >> 4, c4 = 4 * (tid & 15), cB = hd * 64 + c4;
    const f32x4 mur = *(const f32x4*)(p.in[I_RMU] + cB), muk = *(const f32x4*)(p.in[I_RMU] + 1024 + cB), muv = *(const f32x4*)(p.in[I_RMU] + 2048 + cB);
    const f32x4 kkc = *(const f32x4*)(p.in[I_RKK] + cB), kac = *(const f32x4*)(p.in[I_RKA] + cB), rkc = *(const f32x4*)(p.in[I_RRK] + cB);
    const int jt = wave >> 1, it0 = (wave & 1) * 2;
    f32x4 sacc[2];
#pragma unroll
    for (int a = 0; a < 2; ++a) {
        const int i = (it0 + a) * 16 + fr, j = jt * 16 + kg * 4;
        sacc[a] = S0 ? *(const f32x4*)(S0 + (size_t)i * 64 + j) : (f32x4){0.f, 0.f, 0.f, 0.f};
        u32x2 o; o.x = pk2(sacc[a][0], sacc[a][1]); o.y = pk2(sacc[a][2], sacc[a][3]); *(u32x2*)(Sb + i * VP + j) = o;
    }

    for (int i = tid; i < (int)((Ub + 64 * TP40) - NDg) / 2; i += 512) ((unsigned*)NDg)[i] = 0u;
    RwkvRaw raw;
#define RW_LOAD(s0_) do { \
        _Pragma("unroll") for (int tt = 0; tt < 2; ++tt) { const int tkA = z ? (T - 1 - ((s0_) + tt * 16 + fr)) : ((s0_) + tt * 16 + fr); \
            const bf16_t* xr = XL + (size_t)(row0 + tkA) * 256 + type * 128 + z * 64 + kg * 8; \
            raw.xl[tt][0] = *(const u32x4*)(xr); raw.xl[tt][1] = *(const u32x4*)(xr + 32); } \
        const int tkL = z ? (T - 1 - ((s0_) + pB)) : ((s0_) + pB), rowL = row0 + tkL; \
        int n_[4]; bool k_[4]; nbrs(rowL, n_[0], n_[1], n_[2], n_[3], k_[0], k_[1], k_[2], k_[3]); \
        const bf16_t* pr = P + (size_t)rowL * LDP + cB; \
        raw.own[0] = *(const u32x2*)(pr + C_RR); raw.own[1] = *(const u32x2*)(pr + C_RK); raw.own[2] = *(const u32x2*)(pr + C_RV); \
        _Pragma("unroll") for (int g = 0; g < 4; ++g) { const bf16_t* pn = P + (size_t)n_[g] * LDP + cB; const u32x2 z2 = (u32x2){0u, 0u}; \
            raw.nb[g][0] = k_[g] ? *(const u32x2*)(pn + C_RR) : z2; raw.nb[g][1] = k_[g] ? *(const u32x2*)(pn + C_RK) : z2; raw.nb[g][2] = k_[g] ? *(const u32x2*)(pn + C_RV) : z2; } \
    } while (0)

    RW_LOAD(0);
    {
        {
            float lwv[2][4];
#pragma unroll
            for (int tt = 0; tt < 2; ++tt) {
                f32x4 acc = (f32x4){0.f, 0.f, 0.f, 0.f};
                acc = __builtin_amdgcn_mfma_f32_16x16x32_bf16(__builtin_bit_cast(bf16x8, raw.xl[tt][0]), Bfrag[0], acc, 0, 0, 0);
                acc = __builtin_amdgcn_mfma_f32_16x16x32_bf16(__builtin_bit_cast(bf16x8, raw.xl[tt][1]), Bfrag[1], acc, 0, 0, 0);
#pragma unroll
                for (int j = 0; j < 4; ++j) { const int pp = tt * 16 + kg * 4 + j; const float x = biasA + acc[j];
                    if (type == 0) { const float lw = -0.60653066f * __builtin_amdgcn_rcpf(1.f + __expf(-x)); lwv[tt][j] = lw; LW[pp * 64 + ccA] = lw; }
                    else { lwv[tt][j] = 0.f; AA[pp * 64 + ccA] = __builtin_amdgcn_rcpf(1.f + __expf(-x)); } }
            }
            if (type == 0) { float carry = 0.f;
#pragma unroll
                for (int tt = 0; tt < 2; ++tt) {
                    const float p0 = lwv[tt][0], p1 = p0 + lwv[tt][1], p2 = p1 + lwv[tt][2], p3 = p2 + lwv[tt][3];
                    float inc = p3; const float t1 = __shfl_up(inc, 16); if (lane >= 16) inc += t1; const float t2 = __shfl_up(inc, 32); if (lane >= 32) inc += t2;
                    const float ex = inc - p3 + carry; const int pp = tt * 16 + kg * 4;
                    DL[(pp + 0) * 64 + ccA] = ex + p0; DL[(pp + 1) * 64 + ccA] = ex + p1; DL[(pp + 2) * 64 + ccA] = ex + p2; DL[(pp + 3) * 64 + ccA] = ex + p3;
                    carry += __shfl(inc, 48 + fr); } }
        }
    }
    __syncthreads();
    for (int s0 = 0; s0 < T; s0 += RCH) {
        {
            const int tkB = z ? (T - 1 - (s0 + pB)) : (s0 + pB), rowB = row0 + tkB;
            f32x4 rs, ks, vs;
            rs.x = shift_mix(bflo(raw.own[0].x), bflo(raw.nb[0][0].x), mur.x); rs.y = shift_mix(bfhi(raw.own[0].x), bfhi(raw.nb[1][0].x), mur.y);
            rs.z = shift_mix(bflo(raw.own[0].y), bflo(raw.nb[2][0].y), mur.z); rs.w = shift_mix(bfhi(raw.own[0].y), bfhi(raw.nb[3][0].y), mur.w);
            ks.x = shift_mix(bflo(raw.own[1].x), bflo(raw.nb[0][1].x), muk.x); ks.y = shift_mix(bfhi(raw.own[1].x), bfhi(raw.nb[1][1].x), muk.y);
            ks.z = shift_mix(bflo(raw.own[1].y), bflo(raw.nb[2][1].y), muk.z); ks.w = shift_mix(bfhi(raw.own[1].y), bfhi(raw.nb[3][1].y), muk.w);
            vs.x = shift_mix(bflo(raw.own[2].x), bflo(raw.nb[0][2].x), muv.x); vs.y = shift_mix(bfhi(raw.own[2].x), bfhi(raw.nb[1][2].x), muv.y);
            vs.z = shift_mix(bflo(raw.own[2].y), bflo(raw.nb[2][2].y), muv.z); vs.w = shift_mix(bfhi(raw.own[2].y), bfhi(raw.nb[3][2].y), muv.w);
            f32x4 kk = ks * kkc;
            const float nn = red16((kk.x * kk.x + kk.y * kk.y) + (kk.z * kk.z + kk.w * kk.w));
            kk = kk * fminf(__builtin_amdgcn_rsqf(nn), 1e12f);
            const f32x4 a = *(const f32x4*)(AA + pB * 64 + c4), lw = *(const f32x4*)(LW + pB * 64 + c4), dl = *(const f32x4*)(DL + pB * 64 + c4);
            const f32x4 bv = kk * a; const f32x4 kz = ks * (1.f + (a - 1.f) * kac);
            const f32x4 t1_ = rs * kz;
            const float bon = red16((t1_.x * rkc.x + t1_.y * rkc.y) + (t1_.z * rkc.z + t1_.w * rkc.w));
            f32x4 eD, eP, iD;
            eD.x = __expf(dl.x); eD.y = __expf(dl.y); eD.z = __expf(dl.z); eD.w = __expf(dl.w);
            eP.x = __expf(dl.x - lw.x); eP.y = __expf(dl.y - lw.y); eP.z = __expf(dl.z - lw.z); eP.w = __expf(dl.w - lw.w);
            iD.x = __expf(-dl.x); iD.y = __expf(-dl.y); iD.z = __expf(-dl.z); iD.w = __expf(-dl.w);
            const f32x4 al = -(kk * eP), rh = rs * eD, be = bv * iD, ka = kz * iD;
            u32x2 o;
            o.x = pk2(al.x, al.y); o.y = pk2(al.z, al.w); *(u32x2*)(ALb + pB * VP + c4) = o;
            o.x = pk2(rh.x, rh.y); o.y = pk2(rh.z, rh.w); *(u32x2*)(RHb + pB * VP + c4) = o;
            o.x = pk2(be.x, be.y); o.y = pk2(be.z, be.w); *(u32x2*)(BEb + pB * VP + c4) = o;
            o.x = pk2(ka.x, ka.y); o.y = pk2(ka.z, ka.w); *(u32x2*)(KAb + pB * VP + c4) = o;
            { const unsigned b0 = pk2(be.x, be.y), b1 = pk2(be.z, be.w), k0_ = pk2(ka.x, ka.y), k1_ = pk2(ka.z, ka.w), v0_ = pk2(vs.x, vs.y), v1_ = pk2(vs.z, vs.w);
              BET[(c4 + 0) * TP40 + pB] = (bf16_t)b0; BET[(c4 + 1) * TP40 + pB] = (bf16_t)(b0 >> 16); BET[(c4 + 2) * TP40 + pB] = (bf16_t)b1; BET[(c4 + 3) * TP40 + pB] = (bf16_t)(b1 >> 16);
              KAT[(c4 + 0) * TP40 + pB] = (bf16_t)k0_; KAT[(c4 + 1) * TP40 + pB] = (bf16_t)(k0_ >> 16); KAT[(c4 + 2) * TP40 + pB] = (bf16_t)k1_; KAT[(c4 + 3) * TP40 + pB] = (bf16_t)(k1_ >> 16);
              VVT[(c4 + 0) * TP40 + pB] = (bf16_t)v0_; VVT[(c4 + 1) * TP40 + pB] = (bf16_t)(v0_ >> 16); VVT[(c4 + 2) * TP40 + pB] = (bf16_t)v1_; VVT[(c4 + 3) * TP40 + pB] = (bf16_t)(v1_ >> 16); }
            if ((tid & 15) == 0) BON[(size_t)rowB * 16 + hd] = bon;
            if (z == 0) { u32x2 ov; ov.x = pk2(vs.x, vs.y); ov.y = pk2(vs.z, vs.w); *(u32x2*)(const_cast<bf16_t*>(P) + (size_t)rowB * LDP + C_MQ + cB) = ov; }
            if (pB == RCH - 1) *(f32x4*)(DEND + c4) = eD;
        }
        if (s0 + RCH < T) RW_LOAD(s0 + RCH);
        __syncthreads();
#pragma unroll
        for (int qi = 0; qi < 2; ++qi) {
            const int q = wave + 8 * qi; if (q >= 14) break;
            int grp, mt, nt;
            if (q < 3) { grp = 0; mt = (q == 1) ? 1 : 0; nt = (q == 0) ? 0 : 1; }
            else if (q < 5) { grp = 1; mt = nt = q - 3; }
            else { const int r = (q - 5) % 3; grp = 2 + (q - 5) / 3; mt = (r == 2) ? 1 : 0; nt = (r == 0) ? 0 : 1; }
            const bf16_t* Aop = (grp == 0 || grp == 3) ? BEb : (grp == 1 ? ALb : KAb);
            const bf16_t* Bop = (grp == 1) ? BEb : (grp >= 3 ? RHb : ALb);
            f32x4 d = tile_mm<2>(Aop + mt * 16 * VP, VP, Bop + nt * 16 * VP, VP, fr, kg, (f32x4){0.f, 0.f, 0.f, 0.f});
            const int n = nt * 16 + fr, m0 = mt * 16 + kg * 4;
            f32x4 h = d;
#pragma unroll
            for (int j = 0; j < 4; ++j) { const int m = m0 + j;
                const bool keep = (grp == 1) ? (n < m) : ((grp >= 3) ? (m <= n) : (m < n));
                d[j] = keep ? d[j] : 0.f; h[j] = d[j] + ((m == n) ? 1.f : 0.f); }
            if (grp == 0) {
                if (mt == nt) { store_nat(NDt + mt * 16 * TP40, TP40, 0, 0, fr, kg, d, zv); store_nat(HD + mt * 16 * TP40, TP40, 0, 0, fr, kg, h, zv); }
                else store_nat(N12T, TP40, 0, 0, fr, kg, d, zv);
            } else if (grp == 1) store_nat(NDg + mt * 16 * TP40, TP40, 0, 0, fr, kg, d, zv);
            else store_nat(grp == 2 ? TKT : (grp == 3 ? PBT : PKT), TP40, nt * 16, mt * 16, fr, kg, d, zv);
        }
        __syncthreads();
        const int tt = wave >> 2, itw = wave & 3;
        {
            f32x4 d = tile_mm<2>(ALb + tt * 16 * VP, VP, Sb + itw * 16 * VP, VP, fr, kg, (f32x4){0.f, 0.f, 0.f, 0.f});
            d = tile_mm<1>(TKT + tt * 16 * TP40, TP40, VVT + itw * 16 * TP40, TP40, fr, kg, d);
            store_nat(Wb, TP40, itw * 16, tt * 16, fr, kg, d, zv);
        }
        if (wave < 2) {
            const int blk = wave;
#define ND_G(buf) (NDg + ((buf) * 2 + blk) * 16 * TP40)
#define ND_T(buf) (NDt + ((buf) * 2 + blk) * 16 * TP40)
#define HD_(buf) (HD + ((buf) * 2 + blk) * 16 * TP40)
#define LWAIT() asm volatile("s_waitcnt lgkmcnt(0)" ::: "memory")
            const f32x4 zf = (f32x4){0.f, 0.f, 0.f, 0.f};
#pragma unroll
            for (int st = 1; st <= 4; ++st) {
                const int cur = (st - 1) & 1, nxt = st & 1;
                LWAIT();
                if (st >= 2) {
                    const bf16_t* Ho = HD_(st & 1);
                    f32x4 d = tile_mm<1>(ND_G(cur), TP40, Ho, TP40, fr, kg, zf);
                    const u32x2 ho = *(const u32x2*)(Ho + fr * TP40 + kg * 4);
                    d[0] += bflo(ho.x); d[1] += bfhi(ho.x); d[2] += bflo(ho.y); d[3] += bfhi(ho.y);
                    if (st < 4) store_nat(HD_((st + 1) & 1), TP40, 0, 0, fr, kg, d, zv);
                    else store_nat(HH, TP40, blk * 16, blk * 16, fr, kg, d, zv);
                }
                if (st <= 3) {
                    const f32x4 dg = tile_mm<1>(ND_T(cur), TP40, ND_G(cur), TP40, fr, kg, zf);
                    const f32x4 dt = tile_mm<1>(ND_G(cur), TP40, ND_T(cur), TP40, fr, kg, zf);
                    store_nat(ND_G(nxt), TP40, 0, 0, fr, kg, dg, zv); store_nat(ND_T(nxt), TP40, 0, 0, fr, kg, dt, zv);
                }
            }
#undef ND_G
#undef ND_T
#undef HD_
        }
        __syncthreads();
        if (wave < 4) {
            const int it = wave;
            const f32x4 zf = (f32x4){0.f, 0.f, 0.f, 0.f};
            f32x4 d = tile_mm<1>(HH, TP40, Wb + it * 16 * TP40, TP40, fr, kg, zf);
            store_nat(Ub, TP40, it * 16, 0, fr, kg, d, zv);
            LWAIT();
            d = tile_mm<1>(N12T, TP40, Ub + it * 16 * TP40, TP40, fr, kg, zf);
            { const u32x2 wo = *(const u32x2*)(Wb + (it * 16 + fr) * TP40 + 16 + kg * 4);
              d[0] += bflo(wo.x); d[1] += bfhi(wo.x); d[2] += bflo(wo.y); d[3] += bfhi(wo.y); }
            store_nat(Wb, TP40, it * 16, 16, fr, kg, d, zv);
            LWAIT();
            d = tile_mm<1>(HH + 16 * TP40, TP40, Wb + it * 16 * TP40, TP40, fr, kg, zf);
            store_nat(Ub, TP40, it * 16, 16, fr, kg, d, zv);
        }
#undef LWAIT
        __syncthreads();
        {
            f32x4 d = tile_mm<2>(RHb + tt * 16 * VP, VP, Sb + itw * 16 * VP, VP, fr, kg, (f32x4){0.f, 0.f, 0.f, 0.f});
            d = tile_mm<1>(PBT + tt * 16 * TP40, TP40, Ub + itw * 16 * TP40, TP40, fr, kg, d);
            d = tile_mm<1>(PKT + tt * 16 * TP40, TP40, VVT + itw * 16 * TP40, TP40, fr, kg, d);
#pragma unroll
            for (int j = 0; j < 4; ++j) { const int t = tt * 16 + kg * 4 + j, tk = z ? (T - 1 - (s0 + t)) : (s0 + t);
                Yout[(size_t)(row0 + tk) * 1024 + hd * 64 + itw * 16 + fr] = (bf16_t)pk2(d[j] + zv, 0.f); }
        }
        const f32x4 dend = *(const f32x4*)(DEND + jt * 16 + kg * 4);
#pragma unroll
        for (int a = 0; a < 2; ++a) {
            f32x4 c = tile_mm<1>(BET + jt * 16 * TP40, TP40, Ub + (it0 + a) * 16 * TP40, TP40, fr, kg, sacc[a]);
            c = tile_mm<1>(KAT + jt * 16 * TP40, TP40, VVT + (it0 + a) * 16 * TP40, TP40, fr, kg, c);
            sacc[a] = c * dend;
        }
        if (s0 + RCH < T) {
        {
            float lwv[2][4];
#pragma unroll
            for (int tt = 0; tt < 2; ++tt) {
                f32x4 acc = (f32x4){0.f, 0.f, 0.f, 0.f};
                acc = __builtin_amdgcn_mfma_f32_16x16x32_bf16(__builtin_bit_cast(bf16x8, raw.xl[tt][0]), Bfrag[0], acc, 0, 0, 0);
                acc = __builtin_amdgcn_mfma_f32_16x16x32_bf16(__builtin_bit_cast(bf16x8, raw.xl[tt][1]), Bfrag[1], acc, 0, 0, 0);
#pragma unroll
                for (int j = 0; j < 4; ++j) { const int pp = tt * 16 + kg * 4 + j; const float x = biasA + acc[j];
                    if (type == 0) { const float lw = -0.60653066f * __builtin_amdgcn_rcpf(1.f + __expf(-x)); lwv[tt][j] = lw; LW[pp * 64 + ccA] = lw; }
                    else { lwv[tt][j] = 0.f; AA[pp * 64 + ccA] = __builtin_amdgcn_rcpf(1.f + __expf(-x)); } }
            }
            if (type == 0) { float carry = 0.f;
#pragma unroll
                for (int tt = 0; tt < 2; ++tt) {
                    const float p0 = lwv[tt][0], p1 = p0 + lwv[tt][1], p2 = p1 + lwv[tt][2], p3 = p2 + lwv[tt][3];
                    float inc = p3; const float t1 = __shfl_up(inc, 16); if (lane >= 16) inc += t1; const float t2 = __shfl_up(inc, 32); if (lane >= 32) inc += t2;
                    const float ex = inc - p3 + carry; const int pp = tt * 16 + kg * 4;
                    DL[(pp + 0) * 64 + ccA] = ex + p0; DL[(pp + 1) * 64 + ccA] = ex + p1; DL[(pp + 2) * 64 + ccA] = ex + p2; DL[(pp + 3) * 64 + ccA] = ex + p3;
                    carry += __shfl(inc, 48 + fr); } }
        }
        }
        __syncthreads();
#pragma unroll
        for (int a = 0; a < 2; ++a) { const int i = (it0 + a) * 16 + fr, j = jt * 16 + kg * 4;
            u32x2 o; o.x = pk2(sacc[a][0], sacc[a][1]); o.y = pk2(sacc[a][2], sacc[a][3]); *(u32x2*)(Sb + i * VP + j) = o; }
    }
#undef RW_LOAD
    if (Sout) {
#pragma unroll
        for (int a = 0; a < 2; ++a) { const int i = (it0 + a) * 16 + fr, j = jt * 16 + kg * 4; *(f32x4*)(Sout + (size_t)i * 64 + j) = sacc[a]; }
    }
    __syncthreads();
}

constexpr int QS = 264, TS72 = 72;
__device__ void mlstm_unit(const Params& p, unsigned char* lds, int row0, int T, int z, int hd, int es,
                           const float* C0, const float* n0, const float* m0p, float* Cout, float* nout, float* mout) {
    const int tid = threadIdx.x, lane = tid & 63, wave = __builtin_amdgcn_readfirstlane(tid >> 6), fr = lane & 15, kg = lane >> 4;
    const bf16_t* P = (const bf16_t*)(p.ws + WS_P);
    const float* G32 = (const float*)(p.ws + WS_G32);
    bf16_t* Q = (bf16_t*)lds;
    bf16_t* Kc = Q + 64 * QS;
    bf16_t* CT = Kc + 64 * QS;
    bf16_t* NVb = CT + 64 * QS;
    bf16_t* WKT = NVb + QS;
    bf16_t* VT = WKT + 256 * TS72;
    bf16_t* AM = VT + 64 * TS72;
    float* NV = (float*)(AM + 64 * TS72);
    float* BB = NV + 256; float* IB = BB + 64; float* MT = IB + 64; float* SIN = MT + 64; float* WF = SIN + 64; float* HD = WF + 64; float* SCAL = HD + 64;
    bf16_t* ONES = (bf16_t*)(SCAL + 4);
    bf16_t* Hout = (bf16_t*)((unsigned char*)p.out + (z ? Y_HB : Y_HF));
    const bf16_t* QKC = (const bf16_t*)(p.ws + WS_QKC);
    const float zvm = opaque_zero();
    const int d8 = tid & 31, pg = tid >> 5;
    const float gbi = p.in[I_GATEB][z * 8 + hd], gbf = p.in[I_GATEB][z * 8 + 4 + hd];
    const int vp = tid >> 3, ve8 = (tid & 7) * 8;
    u32x4 pq[4], pk[4], pv; float pgi = 0.f, pgf = 0.f;
#define ML_LOAD(s0_) do { \
        _Pragma("unroll") for (int i = 0; i < 4; ++i) { const int pp_ = pg + 16 * i, tk_ = z ? (T - 1 - ((s0_) + pp_)) : ((s0_) + pp_); \
            const bf16_t* qr = QKC + (size_t)(row0 + tk_) * 2048 + hd * 256 + d8 * 8; pq[i] = *(const u32x4*)qr; pk[i] = *(const u32x4*)(qr + 1024); } \
        { const int tk_ = z ? (T - 1 - ((s0_) + vp)) : ((s0_) + vp); pv = *(const u32x4*)(P + (size_t)(row0 + tk_) * LDP + C_MV + hd * 256 + es * 64 + ve8); } \
        if (wave == 0) { const int tk_ = z ? (T - 1 - ((s0_) + lane)) : ((s0_) + lane); const float* gr = G32 + (size_t)(row0 + tk_) * 16 + z * 8 + hd; pgi = gr[0]; pgf = gr[4]; } \
    } while (0)
    f32x4 cacc[2][4];
#pragma unroll
    for (int a = 0; a < 2; ++a)
#pragma unroll
        for (int et = 0; et < 4; ++et) {
#pragma unroll
            for (int j = 0; j < 4; ++j) { const int d = (2 * wave + a) * 16 + kg * 4 + j, e = et * 16 + fr;
                cacc[a][et][j] = C0 ? C0[(size_t)d * 256 + es * 64 + e] : 0.f; }
            const int d = (2 * wave + a) * 16 + kg * 4, e = et * 16 + fr;
            u32x2 o; o.x = pk2(cacc[a][et][0], cacc[a][et][1]); o.y = pk2(cacc[a][et][2], cacc[a][et][3]);
            *(u32x2*)(CT + e * QS + d) = o;
        }
    if (tid < 256) { const float nv0 = n0 ? n0[tid] : 0.f; NV[tid] = nv0; NVb[tid] = (bf16_t)pk2(nv0, 0.f); }
    if (tid < 8) NVb[256 + tid] = (bf16_t)0u;
    for (int i = tid; i < 16 * TS72; i += 512) ONES[i] = (bf16_t)((i < 64) ? 0x3F80u : 0u);
    float m = m0p ? m0p[0] : -INFINITY;
    ML_LOAD(0);
    __syncthreads();

    for (int s0 = 0; s0 < T; s0 += 64) {
        if (wave == 0) {
            const float ig = pgi + gbi;
            const float fpre = pgf + gbf;
            const float fg = -(fmaxf(-fpre, 0.f) + (__builtin_amdgcn_logf(1.f + __expf(-fabsf(fpre))) * 0.69314718f));
            const float b = wave_scan_add(fg);
            const float ib = ig - b; const float cm = wave_scan_max(ib);
            const float bL = lane63(b);
            const float mt = b + fmaxf(m, cm);
            const float g = bL + ib; const float gmax = lane63(cm) + bL;
            const float m_new = fmaxf(bL + m, gmax);
            BB[lane] = b; IB[lane] = ib; MT[lane] = mt; SIN[lane] = __expf(b + m - mt); WF[lane] = __expf(g - m_new);
            if (lane == 0) { SCAL[0] = __expf(bL + m - m_new); SCAL[1] = m_new; }
        }
#pragma unroll
        for (int i = 0; i < 4; ++i) { const int pp = pg + 16 * i; *(u32x4*)(Q + pp * QS + d8 * 8) = pq[i]; *(u32x4*)(Kc + pp * QS + d8 * 8) = pk[i]; }
        VT[(ve8 + 0) * TS72 + vp] = (bf16_t)(pv.x & 0xffffu); VT[(ve8 + 1) * TS72 + vp] = (bf16_t)(pv.x >> 16);
        VT[(ve8 + 2) * TS72 + vp] = (bf16_t)(pv.y & 0xffffu); VT[(ve8 + 3) * TS72 + vp] = (bf16_t)(pv.y >> 16);
        VT[(ve8 + 4) * TS72 + vp] = (bf16_t)(pv.z & 0xffffu); VT[(ve8 + 5) * TS72 + vp] = (bf16_t)(pv.z >> 16);
        VT[(ve8 + 6) * TS72 + vp] = (bf16_t)(pv.w & 0xffffu); VT[(ve8 + 7) * TS72 + vp] = (bf16_t)(pv.w >> 16);
        __syncthreads();
        if (s0 + 64 < T) ML_LOAD(s0 + 64);
        {
            const int d = tid & 255, ph = tid >> 8;
#pragma unroll
            for (int i = 0; i < 4; ++i) { const int po = ph * 4 + i; float w[8];
#pragma unroll
                for (int j = 0; j < 8; ++j) w[j] = WF[po * 8 + j] * bf2f((unsigned)Kc[(po * 8 + j) * QS + d]);
                u32x4 o; o.x = pk2(w[0], w[1]); o.y = pk2(w[2], w[3]); o.z = pk2(w[4], w[5]); o.w = pk2(w[6], w[7]);
                *(u32x4*)(WKT + d * TS72 + po * 8) = o; }
        }
        {
            const int tr = wave >> 1, tc0 = (wave & 1) * 2;
            f32x4 a0 = (f32x4){0.f, 0.f, 0.f, 0.f}, a1 = a0;
#pragma unroll
            for (int kk = 0; kk < 8; ++kk) {
                const bf16x8 af = *(const bf16x8*)(Q + (tr * 16 + fr) * QS + kk * 32 + kg * 8);
                const bf16x8 b0 = *(const bf16x8*)(Kc + (tc0 * 16 + fr) * QS + kk * 32 + kg * 8);
                const bf16x8 b1 = *(const bf16x8*)(Kc + ((tc0 + 1) * 16 + fr) * QS + kk * 32 + kg * 8);
                a0 = __builtin_amdgcn_mfma_f32_16x16x32_bf16(af, b0, a0, 0, 0, 0);
                a1 = __builtin_amdgcn_mfma_f32_16x16x32_bf16(af, b1, a1, 0, 0, 0);
            }
#pragma unroll
            for (int j = 0; j < 4; ++j) { const int t = tr * 16 + kg * 4 + j; const float bt = BB[t] - MT[t];
                { const int s = tc0 * 16 + fr; const float w = __expf(fminf(bt + IB[s], 0.f)) * ((s <= t) ? a0[j] : 0.f); AM[t * TS72 + s] = (bf16_t)pk2(w, w); }
                { const int s = (tc0 + 1) * 16 + fr; const float w = __expf(fminf(bt + IB[s], 0.f)) * ((s <= t) ? a1[j] : 0.f); AM[t * TS72 + s] = (bf16_t)pk2(w, w); } }
        }
        __syncthreads();
        f32x4 X0, X1, Y0, Y1;
        const int tr3 = wave >> 1, te0 = (wave & 1) * 2;
        {
            X0 = (f32x4){0.f, 0.f, 0.f, 0.f}; X1 = X0; Y0 = X0; Y1 = X0;
            f32x4 QN = X0, AS = X0;
            const bool dw = (te0 == 0);
#pragma unroll
            for (int kk = 0; kk < 8; ++kk) {
                const bf16x8 af = *(const bf16x8*)(Q + (tr3 * 16 + fr) * QS + kk * 32 + kg * 8);
                const bf16x8 b0 = *(const bf16x8*)(CT + (te0 * 16 + fr) * QS + kk * 32 + kg * 8);
                const bf16x8 b1 = *(const bf16x8*)(CT + ((te0 + 1) * 16 + fr) * QS + kk * 32 + kg * 8);
                X0 = __builtin_amdgcn_mfma_f32_16x16x32_bf16(af, b0, X0, 0, 0, 0);
                X1 = __builtin_amdgcn_mfma_f32_16x16x32_bf16(af, b1, X1, 0, 0, 0);
                if (dw) { const bf16x8 bn = *(const bf16x8*)(CT + (64 + fr) * QS + kk * 32 + kg * 8); QN = __builtin_amdgcn_mfma_f32_16x16x32_bf16(af, bn, QN, 0, 0, 0); }
            }
#pragma unroll
            for (int kk = 0; kk < 2; ++kk) {
                const bf16x8 af = *(const bf16x8*)(AM + (tr3 * 16 + fr) * TS72 + kk * 32 + kg * 8);
                const bf16x8 b0 = *(const bf16x8*)(VT + (te0 * 16 + fr) * TS72 + kk * 32 + kg * 8);
                const bf16x8 b1 = *(const bf16x8*)(VT + ((te0 + 1) * 16 + fr) * TS72 + kk * 32 + kg * 8);
                Y0 = __builtin_amdgcn_mfma_f32_16x16x32_bf16(af, b0, Y0, 0, 0, 0);
                Y1 = __builtin_amdgcn_mfma_f32_16x16x32_bf16(af, b1, Y1, 0, 0, 0);
                if (dw) { const bf16x8 bo = *(const bf16x8*)(ONES + fr * TS72 + kk * 32 + kg * 8); AS = __builtin_amdgcn_mfma_f32_16x16x32_bf16(af, bo, AS, 0, 0, 0); }
            }
            if (dw && fr == 0) {
#pragma unroll
                for (int j = 0; j < 4; ++j) { const int t = tr3 * 16 + kg * 4 + j; const float den = SIN[t] * QN[j] + AS[j]; HD[t] = 1.f / fmaxf(fabsf(den), __expf(-MT[t])); }
            }
        }
        __syncthreads();
        {
#pragma unroll
            for (int j = 0; j < 4; ++j) { const int t = tr3 * 16 + kg * 4 + j; const float si = SIN[t], hd_ = HD[t];
                const int tk = z ? (T - 1 - (s0 + t)) : (s0 + t), row = row0 + tk;
                bf16_t* hp = Hout + (size_t)row * 1024 + hd * 256 + es * 64;
                hp[te0 * 16 + fr] = (bf16_t)pk2((si * X0[j] + Y0[j]) * hd_, 0.f);
                hp[(te0 + 1) * 16 + fr] = (bf16_t)pk2((si * X1[j] + Y1[j]) * hd_, 0.f); }
        }
        {
            const float decay = SCAL[0];
            bf16x8 wf4[2][2];
#pragma unroll
            for (int a = 0; a < 2; ++a) { wf4[a][0] = *(const bf16x8*)(WKT + ((2 * wave + a) * 16 + fr) * TS72 + kg * 8); wf4[a][1] = *(const bf16x8*)(WKT + ((2 * wave + a) * 16 + fr) * TS72 + 32 + kg * 8); }
#pragma unroll
            for (int et = 0; et < 4; ++et) {
                const bf16x8 bv0 = *(const bf16x8*)(VT + (et * 16 + fr) * TS72 + kg * 8), bv1 = *(const bf16x8*)(VT + (et * 16 + fr) * TS72 + 32 + kg * 8);
#pragma unroll
                for (int a = 0; a < 2; ++a) {
                    f32x4 c = cacc[a][et] * decay;
                    c = __builtin_amdgcn_mfma_f32_16x16x32_bf16(wf4[a][0], bv0, c, 0, 0, 0);
                    c = __builtin_amdgcn_mfma_f32_16x16x32_bf16(wf4[a][1], bv1, c, 0, 0, 0);
                    cacc[a][et] = c;
                    const int d = (2 * wave + a) * 16 + kg * 4, e = et * 16 + fr;
                    const f32x4 cz = c + zvm;
                    u32x2 o; o.x = pk2(cz[0], cz[1]); o.y = pk2(cz[2], cz[3]);
                    *(u32x2*)(CT + e * QS + d) = o;
                }
            }
            {
                const bf16x8 on0 = *(const bf16x8*)(ONES + fr * TS72 + kg * 8), on1 = *(const bf16x8*)(ONES + fr * TS72 + 32 + kg * 8);
#pragma unroll
                for (int a = 0; a < 2; ++a) {
                    f32x4 ns = __builtin_amdgcn_mfma_f32_16x16x32_bf16(wf4[a][0], on0, (f32x4){0.f, 0.f, 0.f, 0.f}, 0, 0, 0);
                    ns = __builtin_amdgcn_mfma_f32_16x16x32_bf16(wf4[a][1], on1, ns, 0, 0, 0);
                    if (fr == 0) { const int d0 = (2 * wave + a) * 16 + kg * 4; float* nv = NV + d0;
                        const float n0_ = decay * nv[0] + ns[0], n1_ = decay * nv[1] + ns[1], n2_ = decay * nv[2] + ns[2], n3_ = decay * nv[3] + ns[3];
                        nv[0] = n0_; nv[1] = n1_; nv[2] = n2_; nv[3] = n3_;
                        u32x2 nb2; nb2.x = pk2(n0_, n1_); nb2.y = pk2(n2_, n3_); *(u32x2*)(NVb + d0) = nb2; }
                }
            }
            m = SCAL[1];
        }
        __syncthreads();
    }
    if (Cout) {
#pragma unroll
        for (int a = 0; a < 2; ++a)
#pragma unroll
            for (int et = 0; et < 4; ++et)
#pragma unroll
                for (int j = 0; j < 4; ++j) { const int d = (2 * wave + a) * 16 + kg * 4 + j, e = et * 16 + fr; Cout[(size_t)d * 256 + es * 64 + e] = cacc[a][et][j]; }
        if (es == 0) { if (tid < 256) nout[tid] = NV[tid]; if (tid == 0) mout[0] = m; }
    }
    __syncthreads();
#undef ML_LOAD
}

__device__ __forceinline__ void phase3(const Params& p, unsigned char* lds) {
    const int blk = blockIdx.x;
#ifndef SK3A
    if (p.sub != 2)
    {
    {
        const int b = blk >> 5, hd = (blk >> 1) & 15, z = blk & 1;
        rwkv_chain(p, lds, NPROMPT + b * TS, TS, z, hd, p.in[I_SS] + ((size_t)(b * 2 + z) * 16 + hd) * 4096, nullptr);
    }
    for (int k = 0; k < 2; ++k) {
        const int u = 2 * blk + k, b = u >> 5, hd = (u >> 1) & 15, z = u & 1;
        rwkv_chain(p, lds, b * TP, TP, z, hd, nullptr, p.out + O_S + ((size_t)(b * 2 + z) * 16 + hd) * 4096);
    }
    }
#endif
#ifndef SK3B
    if (p.sub != 1) {
    {
        const int es = blk & 3, z = (blk >> 2) & 1, hd = (blk >> 3) & 3, b = blk >> 5;
        const size_t ci = (size_t)(b * 2 + z) * 4 + hd;
        mlstm_unit(p, lds, NPROMPT + b * TS, TS, z, hd, es, p.in[I_SC] + ci * 65536, p.in[I_SN] + ci * 256, p.in[I_SM] + ci, nullptr, nullptr, nullptr);
    }
    for (int k = 0; k < 2; ++k) {
        const int u = 2 * blk + k, es = u & 3, z = (u >> 2) & 1, hd = (u >> 3) & 3, b = u >> 5;
        const size_t ci = (size_t)(b * 2 + z) * 4 + hd;
        mlstm_unit(p, lds, b * TP, TP, z, hd, es, nullptr, nullptr, nullptr, p.out + O_C + ci * 65536, p.out + O_N + ci * 256, p.out + O_M + ci);
    }
    }
#endif
}

__device__ __forceinline__ void phase4(const Params& p) {
    const int tid = threadIdx.x, lane = tid & 63, wave = __builtin_amdgcn_readfirstlane(tid >> 6);
    bf16_t* P = (bf16_t*)(p.ws + WS_P);
    const bf16_t* HF = (const bf16_t*)((unsigned char*)p.out + Y_HF); const bf16_t* HB = (const bf16_t*)((unsigned char*)p.out + Y_HB);
    const bf16_t* YF = (const bf16_t*)((unsigned char*)p.out + Y_YF); const bf16_t* YB = (const bf16_t*)((unsigned char*)p.out + Y_YB);
    const float* BON = (const float*)(p.ws + WS_BON);
    f32x4 pmg[4], plg[4], plb[4];
#pragma unroll
    for (int j = 0; j < 4; ++j) { pmg[j] = *(const f32x4*)(p.in[I_MLNG] + 16 * lane + 4 * j); plg[j] = *(const f32x4*)(p.in[I_RLNG] + 16 * lane + 4 * j); plb[j] = *(const f32x4*)(p.in[I_RLNB] + 16 * lane + 4 * j); }
    for (int row = blockIdx.x * 8 + wave; row < MROWS; row += gridDim.x * 8) {
        bf16_t* prow = P + (size_t)row * LDP;
        unsigned outm[8];
        {
            const int c0m = 16 * lane;
            float h[16], zz[16];
#pragma unroll
            for (int h8 = 0; h8 < 2; ++h8) {
                const int c = c0m + 8 * h8;
                const u32x4 hf = __builtin_nontemporal_load((const u32x4*)(HF + (size_t)row * 1024 + c)), hb = __builtin_nontemporal_load((const u32x4*)(HB + (size_t)row * 1024 + c));
                const u32x4 mo = __builtin_nontemporal_load((const u32x4*)(prow + C_MO + c)), mz = __builtin_nontemporal_load((const u32x4*)(prow + C_MZ + c));
                float* hh = h + 8 * h8; float* zp = zz + 8 * h8;
                hh[0] = sigmoid_f(bflo(mo.x)) * (bflo(hf.x) + bflo(hb.x)); hh[1] = sigmoid_f(bfhi(mo.x)) * (bfhi(hf.x) + bfhi(hb.x));
                hh[2] = sigmoid_f(bflo(mo.y)) * (bflo(hf.y) + bflo(hb.y)); hh[3] = sigmoid_f(bfhi(mo.y)) * (bfhi(hf.y) + bfhi(hb.y));
                hh[4] = sigmoid_f(bflo(mo.z)) * (bflo(hf.z) + bflo(hb.z)); hh[5] = sigmoid_f(bfhi(mo.z)) * (bfhi(hf.z) + bfhi(hb.z));
                hh[6] = sigmoid_f(bflo(mo.w)) * (bflo(hf.w) + bflo(hb.w)); hh[7] = sigmoid_f(bfhi(mo.w)) * (bfhi(hf.w) + bfhi(hb.w));
                zp[0] = silu_f(bflo(mz.x)); zp[1] = silu_f(bfhi(mz.x)); zp[2] = silu_f(bflo(mz.y)); zp[3] = silu_f(bfhi(mz.y));
                zp[4] = silu_f(bflo(mz.z)); zp[5] = silu_f(bfhi(mz.z)); zp[6] = silu_f(bflo(mz.w)); zp[7] = silu_f(bfhi(mz.w));
            }
            float sm = 0.f;
#pragma unroll
            for (int j = 0; j < 16; ++j) sm += h[j];
            const float mu = red16(sm) * (1.f / 256.f);
            float sq = 0.f;
#pragma unroll
            for (int j = 0; j < 16; ++j) { h[j] -= mu; sq += h[j] * h[j]; }
            const float rstd = rsqrtf(red16(sq) * (1.f / 256.f) + EPS);
#pragma unroll
            for (int j = 0; j < 8; ++j) outm[j] = pk2(h[2 * j] * rstd * pmg[j >> 1][(2 * j) & 3] * zz[2 * j], h[2 * j + 1] * rstd * pmg[j >> 1][(2 * j + 1) & 3] * zz[2 * j + 1]);
        }
        const int c0 = 16 * lane, hd = lane >> 2;
        float y[16], vs[16];
        const float bon = BON[(size_t)row * 16 + hd] + BON[(size_t)(MROWS + row) * 16 + hd];
#pragma unroll
        for (int h8 = 0; h8 < 2; ++h8) {
            const int c = c0 + 8 * h8;
            const u32x4 yf = __builtin_nontemporal_load((const u32x4*)(YF + (size_t)row * 1024 + c)), yb = __builtin_nontemporal_load((const u32x4*)(YB + (size_t)row * 1024 + c));
            const u32x4 vo = *(const u32x4*)(prow + C_MQ + c);
            float* yy = y + 8 * h8; float* vv = vs + 8 * h8;
            yy[0] = bflo(yf.x) + bflo(yb.x); yy[1] = bfhi(yf.x) + bfhi(yb.x); yy[2] = bflo(yf.y) + bflo(yb.y); yy[3] = bfhi(yf.y) + bfhi(yb.y);
            yy[4] = bflo(yf.z) + bflo(yb.z); yy[5] = bfhi(yf.z) + bfhi(yb.z); yy[6] = bflo(yf.w) + bflo(yb.w); yy[7] = bfhi(yf.w) + bfhi(yb.w);
            vv[0] = bflo(vo.x); vv[1] = bfhi(vo.x); vv[2] = bflo(vo.y); vv[3] = bfhi(vo.y); vv[4] = bflo(vo.z); vv[5] = bfhi(vo.z); vv[6] = bflo(vo.w); vv[7] = bfhi(vo.w);
        }
        float s = 0.f;
#pragma unroll
        for (int j = 0; j < 16; ++j) s += y[j];
        const float ym = red4(s) * (1.f / 64.f);
        float s2 = 0.f;
#pragma unroll
        for (int j = 0; j < 16; ++j) { y[j] -= ym; s2 += y[j] * y[j]; }
        const float rstd = rsqrtf(red4(s2) * (1.f / 64.f) + LNX_EPS);
        unsigned outr[8];
#pragma unroll
        for (int h8 = 0; h8 < 2; ++h8) {
            const int c = c0 + 8 * h8;
            const u32x4 rz = __builtin_nontemporal_load((const u32x4*)(prow + C_RZ + c));
            float o[8];
#pragma unroll
            for (int j = 0; j < 8; ++j) o[j] = y[8 * h8 + j] * rstd * plg[2 * h8 + (j >> 2)][j & 3] + plb[2 * h8 + (j >> 2)][j & 3] + bon * vs[8 * h8 + j];
            o[0] *= silu_f(bflo(rz.x)); o[1] *= silu_f(bfhi(rz.x)); o[2] *= silu_f(bflo(rz.y)); o[3] *= silu_f(bfhi(rz.y));
            o[4] *= silu_f(bflo(rz.z)); o[5] *= silu_f(bfhi(rz.z)); o[6] *= silu_f(bflo(rz.w)); o[7] *= silu_f(bfhi(rz.w));
            outr[4 * h8 + 0] = pk2(o[0], o[1]); outr[4 * h8 + 1] = pk2(o[2], o[3]); outr[4 * h8 + 2] = pk2(o[4], o[5]); outr[4 * h8 + 3] = pk2(o[6], o[7]);
        }
        *(u32x4*)(prow + 16 * lane) = (u32x4){outm[0], outm[1], outm[2], outm[3]};
        *(u32x4*)(prow + 16 * lane + 8) = (u32x4){outm[4], outm[5], outm[6], outm[7]};
        *(u32x4*)(prow + 1024 + c0) = (u32x4){outr[0], outr[1], outr[2], outr[3]};
        *(u32x4*)(prow + 1024 + c0 + 8) = (u32x4){outr[4], outr[5], outr[6], outr[7]};
    }
}

__device__ __forceinline__ void phase6(const Params& p) {
    const int tid = threadIdx.x, lane = tid & 63, wave = __builtin_amdgcn_readfirstlane(tid >> 6);
    const float* fg = p.in[I_FINALG];
    const bf16_t* XN = (const bf16_t*)(p.ws + WS_QKC);
    f32x4 g[4][2];
#pragma unroll
    for (int j = 0; j < 4; ++j) { g[j][0] = *(const f32x4*)(fg + 8 * lane + 512 * j); g[j][1] = *(const f32x4*)(fg + 8 * lane + 512 * j + 4); }
    for (int row = blockIdx.x * 8 + wave; row < MROWS; row += gridDim.x * 8) {
        u32x4 v[4]; float ss = 0.f;
#pragma unroll
        for (int j = 0; j < 4; ++j) v[j] = __builtin_nontemporal_load((const u32x4*)(XN + (size_t)row * DM + 8 * lane + 512 * j));
        f32x4 a[4][2];
#pragma unroll
        for (int j = 0; j < 4; ++j) { a[j][0] = (f32x4){bflo(v[j].x), bfhi(v[j].x), bflo(v[j].y), bfhi(v[j].y)}; a[j][1] = (f32x4){bflo(v[j].z), bfhi(v[j].z), bflo(v[j].w), bfhi(v[j].w)};
            ss += (a[j][0].x * a[j][0].x + a[j][0].y * a[j][0].y) + (a[j][0].z * a[j][0].z + a[j][0].w * a[j][0].w) + (a[j][1].x * a[j][1].x + a[j][1].y * a[j][1].y) + (a[j][1].z * a[j][1].z + a[j][1].w * a[j][1].w); }
        const float rstd = rsqrtf(wave_sum(ss) * (1.f / DM) + EPS);
        float* o = p.out + (size_t)row * DM + 8 * lane;
#pragma unroll
        for (int j = 0; j < 4; ++j) { __builtin_nontemporal_store(a[j][0] * rstd * g[j][0], (f32x4*)(o + 512 * j)); __builtin_nontemporal_store(a[j][1] * rstd * g[j][1], (f32x4*)(o + 512 * j + 4)); }
    }
}

#define XB_TMO      128
#define XB_XCNT(j)  (256  + 64 * (j))
#define XB_XSUB(j)  (1280 + 64 * (j))
#define XB_XGEN(j)  (2304 + 64 * (j))
#define XB_TOP      3328
#define XB_TOPGEN   3392
#define XCD_BAR_WORDS 3456
#define XB_SPIN_CAP (1u << 18)
__device__ __forceinline__ unsigned xb_ld(unsigned* p)              { return __hip_atomic_load(p, __ATOMIC_RELAXED, __HIP_MEMORY_SCOPE_AGENT); }
__device__ __forceinline__ unsigned xb_add(unsigned* p, unsigned v) { return __hip_atomic_fetch_add(p, v, __ATOMIC_RELAXED, __HIP_MEMORY_SCOPE_AGENT); }
__device__ __forceinline__ unsigned xb_xcc_id() { return (unsigned)__builtin_amdgcn_s_getreg((3 << 11) | 20) & 0xFu; }
#define XB_SPIN(cond, bar) do { unsigned _sp = 0; while (cond) { __builtin_amdgcn_s_sleep(1); \
    if ((++_sp & 255u) == 0u) { if (xb_ld(&(bar)[XB_TMO])) break; if (_sp > XB_SPIN_CAP) { atomicAdd(&(bar)[XB_TMO], 1u); break; } } } } while (0)
struct XcdBarrier { unsigned* bar; unsigned x; volatile unsigned* st; };
__device__ __forceinline__ XcdBarrier xcd_barrier_post(unsigned* bar, volatile unsigned* st) {
    XcdBarrier b; b.bar = bar; b.x = xb_xcc_id(); b.st = st;
    if (threadIdx.x == 0) (void)xb_add(&bar[XB_XCNT(b.x)], 1u);
    return b;
}
__device__ __forceinline__ void xcd_barrier_complete(unsigned* bar, unsigned x, unsigned& nloc, unsigned& nx) {
    const unsigned G = gridDim.x * gridDim.y * gridDim.z;
    unsigned sum, cnt, mine, sp = 0u;
    for (;;) {
        sum = 0u; cnt = 0u; mine = 0u;
#pragma unroll
        for (unsigned j = 0; j < 16; ++j) { const unsigned c = xb_ld(&bar[XB_XCNT(j)]); sum += c; cnt += (c > 0u) ? 1u : 0u; mine = (j == x) ? c : mine; }
        if (sum == G) break;
        __builtin_amdgcn_s_sleep(1);
        if ((++sp & 255u) == 0u) { if (xb_ld(&bar[XB_TMO])) break; if (sp > XB_SPIN_CAP) { atomicAdd(&bar[XB_TMO], 1u); break; } }
    }
    nloc = mine > 0u ? mine : 1u; nx = cnt > 0u ? cnt : 1u;
}
__device__ __forceinline__ void xcd_barrier(const XcdBarrier& b) {
    asm volatile("s_waitcnt vmcnt(0)" ::: "memory");
    __syncthreads();
    if (threadIdx.x == 0) {
        unsigned* bar = b.bar;
        __builtin_amdgcn_s_waitcnt(0);
        unsigned nloc = b.st[0], nx = b.st[1];
        if (nloc == 0u) { xcd_barrier_complete(bar, b.x, nloc, nx); b.st[0] = nloc; b.st[1] = nx; }
        const unsigned old = xb_add(&bar[XB_XSUB(b.x)], 1u);
        const unsigned gen = old / nloc;
        if (old + 1u == (gen + 1u) * nloc) {
            __builtin_amdgcn_fence(__ATOMIC_RELEASE, "agent");
            asm volatile("s_waitcnt vmcnt(0)" ::: "memory");
            const unsigned og = xb_add(&bar[XB_TOP], 1u);
            const unsigned tg = og / nx;
            if (og + 1u == (tg + 1u) * nx) xb_add(&bar[XB_TOPGEN], 1u);
            else XB_SPIN(xb_ld(&bar[XB_TOPGEN]) == tg, bar);
            __builtin_amdgcn_fence(__ATOMIC_ACQUIRE, "agent");
            xb_add(&bar[XB_XGEN(b.x)], 1u);
            asm volatile("s_waitcnt vmcnt(0)" ::: "memory");
        } else {
            XB_SPIN(xb_ld(&bar[XB_XGEN(b.x)]) == gen, bar);
            __builtin_amdgcn_fence(__ATOMIC_ACQUIRE, "agent");
            asm volatile("s_waitcnt vmcnt(0)" ::: "memory");
        }
    }
    __syncthreads();
}

__global__ void __launch_bounds__(512, 2) mega_fwd(Params p) {
    extern __shared__ __attribute__((aligned(16))) unsigned char lds[];
    cg::grid_group grid = cg::this_grid();
    const int lo = p.ph_lo, hi = p.ph_hi;
#define IN(k) (lo <= (k) && (k) < hi)
    volatile unsigned* bst = (volatile unsigned*)(lds + LDS_BYTES - 16);
    if (threadIdx.x == 0) { bst[0] = 0u; bst[1] = 0u; }
    __syncthreads();
    XcdBarrier xbar; xbar.bar = (unsigned*)(p.ws + WS_BAR); xbar.x = 0; xbar.st = bst;
    if (hi - lo > 1) xbar = xcd_barrier_post((unsigned*)(p.ws + WS_BAR), bst);
    if (lo == 0x7fff) grid.sync();
#define SEAM(k) do { if (IN(k) && IN((k) + 1)) xcd_barrier(xbar); } while (0)
#ifndef SK0
    if (IN(0)) phase0(p, lds);
#endif
    SEAM(0);
#ifndef SK1
    if (IN(1)) phase1(p, lds);
#endif
    SEAM(1);
#ifndef SK2
    if (IN(2)) {
        pg8::Gemm g{(const bf16_t*)((unsigned char*)p.out + Y_H), (const bf16_t*)(p.ws + WS_WINT), MROWS, NPAD, DM, DM};
        pg8::StaticOrder S; S.init(MROWS, NPAD, gridDim.x, (int)blockIdx.x);
        pg8::EpiP E{(bf16_t*)(p.ws + WS_P), (float*)(p.ws + WS_G32)};
        pg8::gemm_phase<pg8::EpiP>((PG8_LAS unsigned char*)lds, g, S, E);
    }
#endif
    SEAM(2);
    if (IN(3)) phase_prep(p);
    SEAM(3);
#ifndef SK3
    if (IN(4)) phase3(p, lds);
#endif
    SEAM(4);
#ifndef SK4
    if (IN(5)) phase4(p);
#endif
    SEAM(5);
#ifndef SK5
    if (IN(6)) {
        pg8::Gemm g{(const bf16_t*)(p.ws + WS_P), (const bf16_t*)(p.ws + WS_WOUTT), MROWS, DM, DM, LDP};
        pg8::StaticOrder S; S.init(MROWS, DM, gridDim.x, (int)blockIdx.x);
        pg8::EpiRes E{p.in[I_XP], p.in[I_XS], (const float*)(p.ws + WS_MOD), (bf16_t*)(p.ws + WS_QKC)};
        pg8::gemm_phase<pg8::EpiRes>((PG8_LAS unsigned char*)lds, g, S, E);
    }
#endif
    SEAM(6);
#ifndef SK6
    if (IN(7)) phase6(p);
#endif
#undef IN
#undef SEAM
}

extern "C" void kernel_launch(void* const* d_in, const int* in_sizes, int n_in, void* d_out, int out_size, void* d_ws, size_t ws_size, hipStream_t stream) {
    static int state = 0;
    if (state == 0) {
        state = 1;
        if (n_in != 28 || ws_size < WS_END) { fprintf(stderr, "kernel_launch: unexpected n_in %d / ws_size %zu (need %zu)\n", n_in, ws_size, (size_t)WS_END); state = -1; }
        if (hipFuncSetAttribute((const void*)mega_fwd, hipFuncAttributeMaxDynamicSharedMemorySize, LDS_BYTES) != hipSuccess) { fprintf(stderr, "kernel_launch: hipFuncSetAttribute failed\n"); state = -1; }
        int per_cu = 0, dev = 0, cus = 0;
        (void)hipGetDevice(&dev); (void)hipDeviceGetAttribute(&cus, hipDeviceAttributeMultiprocessorCount, dev);
        if (hipOccupancyMaxActiveBlocksPerMultiprocessor(&per_cu, (const void*)mega_fwd, 512, LDS_BYTES) != hipSuccess || per_cu < 1 || cus < 256) { fprintf(stderr, "kernel_launch: occupancy %d x %d CUs cannot hold 256 workgroups\n", per_cu, cus); state = -1; }
        (void)hipGetLastError();
    }
    if (state < 0) return;
    if (hipMemsetAsync((char*)d_ws + WS_BAR, 0, 16384, stream) != hipSuccess) { fprintf(stderr, "kernel_launch: memset failed\n"); return; }
    Params p{};
    for (int i = 0; i < 28; ++i) p.in[i] = (const float*)d_in[i];
    p.out = (float*)d_out; p.ws = (unsigned char*)d_ws;
#if REP >= 0
    for (int k = 0; k < 8; ++k) for (int r = 0; r < (k == REP / 10 ? 2 : 1); ++r) { p.ph_lo = k; p.ph_hi = k + 1; p.sub = r ? REP % 10 : 0; hipLaunchKernelGGL(mega_fwd, dim3(256), dim3(512), LDS_BYTES, stream, p); }
#elif N_LAUNCHES == 1
    p.ph_lo = 0; p.ph_hi = 8;
    void* args[] = {&p};
    hipError_t e = hipLaunchCooperativeKernel((void*)mega_fwd, dim3(256), dim3(512), args, LDS_BYTES, stream);
    if (e != hipSuccess) fprintf(stderr, "cooperative launch failed: %s\n", hipGetErrorString(e));
#else
    for (int k = 0; k < 8; ++k) { p.ph_lo = k; p.ph_hi = k + 1; hipLaunchKernelGGL(mega_fwd, dim3(256), dim3(512), LDS_BYTES, stream, p); }
#endif
}
```

```cpp
#include <hip/hip_runtime.h>
#include <hip/hip_cooperative_groups.h>
#include <cstdio>
namespace cg = cooperative_groups;

#ifndef REP
#define REP -1
#endif
#ifndef N_LAUNCHES
#define N_LAUNCHES 1
#endif

typedef unsigned short bf16_t;
typedef short bf16x8 __attribute__((ext_vector_type(8)));
typedef float f32x4 __attribute__((ext_vector_type(4)));
typedef unsigned u32x4 __attribute__((ext_vector_type(4)));
typedef unsigned u32x2 __attribute__((ext_vector_type(2)));

constexpr int DM = 2048, MROWS = 20480, NPROMPT = 4096, TP = 256, TS = 2048;
constexpr int LDP = 9472;
constexpr int NPAD = 9728;
constexpr int C_MQ = 0, C_MK = 1024, C_MV = 2048, C_MO = 3072, C_MZ = 4096, C_RZ = 5120, C_RR = 6144, C_RK = 7168, C_RV = 8192, C_WD = 9216, C_AD = 9344;
constexpr float EPS = 1e-6f, LNX_EPS = 64e-5f;
constexpr int LDS_BYTES = 163840;

constexpr size_t WS_BAR = 0x7C0000, WS_MODP = 0, WS_MOD = 2u << 20, WS_G32 = 3u << 20, WS_BON = 5u << 20, WS_P = 8u << 20;
constexpr size_t WS_WINT = 398458880ull, WS_QKC = WS_WINT  , WS_WOUTT = WS_QKC + (size_t)MROWS * 2048 * 2, WS_XL = WS_WOUTT + (size_t)2048 * 2048 * 2, WS_END = WS_XL + (size_t)MROWS * 256 * 2;
static_assert(WS_END <= 536870912ull, "ws map");
static_assert(WS_P + (size_t)MROWS * LDP * 2 <= WS_WINT, "ws map");
constexpr size_t O_YP = 0, O_YS = 8388608, O_C = 41943040, O_N = 50331648, O_M = 50364416, O_S = 50364544;
constexpr size_t Y_H = 0, Y_HF = 0, Y_HB = 41943040, Y_YF = 83886080, Y_YB = 125829120;

struct Params {
    const float* in[28];
    float* out; unsigned char* ws; int ph_lo, ph_hi, sub, pad;
};
enum { I_XP = 0, I_XS, I_SC, I_SN, I_SM, I_SS, I_C, I_CCTX, I_NORMG, I_WADA, I_BADA, I_WIN, I_CONVW, I_CONVB, I_GATEB, I_MLNG, I_RMU, I_RW0, I_RW2, I_RA0, I_RA2, I_RKK, I_RKA, I_RRK, I_RLNG, I_RLNB, I_WOUT, I_FINALG };

__device__ __forceinline__ float bf2f(unsigned b) { return __uint_as_float(b << 16); }
__device__ __forceinline__ float bflo(unsigned w) { return __uint_as_float(w << 16); }
__device__ __forceinline__ float bfhi(unsigned w) { return __uint_as_float(w & 0xffff0000u); }
__device__ __forceinline__ unsigned pk2(float lo, float hi) { unsigned r; asm("v_cvt_pk_bf16_f32 %0, %1, %2" : "=v"(r) : "v"(lo), "v"(hi)); return r; }
__device__ __forceinline__ unsigned f2bf(float f) { unsigned u = __float_as_uint(f); return (u + 0x7fffu + ((u >> 16) & 1u)) >> 16; }
__device__ __forceinline__ float opaque_zero() { float z; asm volatile("v_mov_b32 %0, 0" : "=v"(z)); return z; }
__device__ __forceinline__ unsigned pk2_sw(float lo, float hi) { return f2bf(lo) | (f2bf(hi) << 16); }
__device__ __forceinline__ float sigmoid_f(float x) { return 1.f / (1.f + __expf(-x)); }
__device__ __forceinline__ float silu_f(float x) { return x / (1.f + __expf(-x)); }
__device__ __forceinline__ float softplus_f(float y) { return fmaxf(y, 0.f) + log1pf(__expf(-fabsf(y))); }
__device__ __forceinline__ float wave_sum(float v) {
#pragma unroll
    for (int o = 1; o < 64; o <<= 1) v += __shfl_xor(v, o);
    return v;
}
__device__ __forceinline__ float dpp_f(float v, const int ctrl_sel) {
    int i = __float_as_int(v), r;
    if (ctrl_sel == 0) r = __builtin_amdgcn_update_dpp(0, i, 0xB1, 0xF, 0xF, true);
    else if (ctrl_sel == 1) r = __builtin_amdgcn_update_dpp(0, i, 0x4E, 0xF, 0xF, true);
    else r = __builtin_amdgcn_update_dpp(0, i, 0x141, 0xF, 0xF, true);
    return __int_as_float(r);
}
__device__ __forceinline__ float red8(float v) { v += dpp_f(v, 0); v += dpp_f(v, 1); v += dpp_f(v, 2); return v; }
__device__ __forceinline__ float red4(float v) { v += dpp_f(v, 0); v += dpp_f(v, 1); return v; }

__device__ __forceinline__ float dpp_id(float ident, float v, const int sel) {
    const int o = __float_as_int(ident), i = __float_as_int(v); int r;
    if (sel == 0) r = __builtin_amdgcn_update_dpp(o, i, 0x111, 0xF, 0xF, false);
    else if (sel == 1) r = __builtin_amdgcn_update_dpp(o, i, 0x112, 0xF, 0xF, false);
    else if (sel == 2) r = __builtin_amdgcn_update_dpp(o, i, 0x114, 0xF, 0xF, false);
    else if (sel == 3) r = __builtin_amdgcn_update_dpp(o, i, 0x118, 0xF, 0xF, false);
    else if (sel == 4) r = __builtin_amdgcn_update_dpp(o, i, 0x142, 0xA, 0xF, false);
    else r = __builtin_amdgcn_update_dpp(o, i, 0x143, 0xC, 0xF, false);
    return __int_as_float(r);
}
__device__ __forceinline__ float wave_scan_add(float v) {
    v += dpp_id(0.f, v, 0); v += dpp_id(0.f, v, 1); v += dpp_id(0.f, v, 2); v += dpp_id(0.f, v, 3); v += dpp_id(0.f, v, 4); v += dpp_id(0.f, v, 5); return v;
}
__device__ __forceinline__ float wave_scan_max(float v) {
    const float ni = -INFINITY;
    v = fmaxf(v, dpp_id(ni, v, 0)); v = fmaxf(v, dpp_id(ni, v, 1)); v = fmaxf(v, dpp_id(ni, v, 2)); v = fmaxf(v, dpp_id(ni, v, 3)); v = fmaxf(v, dpp_id(ni, v, 4)); v = fmaxf(v, dpp_id(ni, v, 5)); return v;
}
__device__ __forceinline__ float lane63(float v) { return __int_as_float(__builtin_amdgcn_readlane(__float_as_int(v), 63)); }
__device__ __forceinline__ int row_rid(int row) { return row < NPROMPT ? 0 : 1 + ((row - NPROMPT) >> 11); }
__device__ __forceinline__ void nbrs(int row, int& n0, int& n1, int& n2, int& n3, bool& k0, bool& k1, bool& k2, bool& k3) {
    if (row < NPROMPT) { const int t = row & 255; n0 = n2 = row - 1; k0 = k2 = t > 0; n1 = n3 = row + 1; k1 = k3 = t < 255; }
    else { const int t = (row - NPROMPT) & 2047, cc = t & 63, gr = t >> 6;
        n0 = row - 1; k0 = cc > 0; n1 = row + 1; k1 = cc < 63; n2 = row - 64; k2 = gr > 0; n3 = row + 64; k3 = gr < 31; }
}

namespace pg8 {
#define PG8_LAS __attribute__((address_space(3)))
constexpr int BM = 256, BK = 64, HALF = 128, HTB = HALF * BK * 2, STAGE_BYTES = 8 * HTB, NXCD = 8, WGM = 8;
__host__ __device__ __forceinline__ int lds_byte(int r, int c) { const int st = (r >> 4) * 2 + (c >> 5), rr = r & 15, cc = c & 31, ob = rr * 64 + cc * 2; return st * 1024 + (ob ^ (((ob >> 9) & 1) << 5)); }
__host__ __device__ __forceinline__ void stage_rc(int b, int& R, int& C) { const int st = b / 1024, sb = b % 1024, swz = sb ^ (((sb >> 9) & 1) << 5); R = (st >> 1) * 16 + swz / 64; C = (st & 1) * 32 + (swz % 64) / 2; }
__host__ __device__ __forceinline__ int perm32(int rho) { const int n = rho >> 4, i = rho & 15; return 8 * (i >> 2) + 4 * n + (i & 3); }
struct Unit { int pm, pn; };
struct Gemm { const bf16_t* A; const bf16_t* Bt; int M, N, K, lda; };
struct StaticOrder {
    int nM, nN, nwg, G, c;
    __host__ __device__ void init(int M, int N, int G_, int c_) { nM = M / BM; nN = N / BM; nwg = nM * nN; G = G_; c = c_; }
    __host__ __device__ bool next(int i, Unit& u) const {
        const long L = (long)i * G + c; if (L >= nwg) return false;
        int wgid = (int)L; { const int q = nwg / NXCD, r = nwg % NXCD, xcd = wgid % NXCD, off = wgid / NXCD; wgid = (xcd < r ? xcd * (q + 1) : r * (q + 1) + (xcd - r) * q) + off; }
        const int nig = WGM * nN, gid = wgid / nig, fm = gid * WGM, gsz = (nM - fm) < WGM ? (nM - fm) : WGM;
        u.pm = fm + ((wgid % nig) % gsz); u.pn = (wgid % nig) / gsz; return true;
    }
};
__device__ __forceinline__ unsigned cvt_pk_bf16(float lo, float hi) { unsigned r; asm volatile("v_cvt_pk_bf16_f32 %0, %1, %2" : "=v"(r) : "v"(lo), "v"(hi)); return r; }

template <class Epi>
__device__ __forceinline__ void gemm_phase(PG8_LAS unsigned char* lds, const Gemm g, const StaticOrder& S, const Epi& E) {
    const int tid = threadIdx.x, wid = __builtin_amdgcn_readfirstlane(tid >> 6), lane = tid & 63, wr = wid >> 2, wc = wid & 3, fr = lane & 15, fq = lane >> 4;
    const int K = g.K, nt = K / BK, lda = g.lda;
    unsigned voffA[2], voffB[2];
#pragma unroll
    for (int i = 0; i < 2; ++i) { int R, C; stage_rc(tid * 16 + i * 8192, R, C); const int Rb = Epi::PERM ? ((R & ~31) + perm32(R & 31)) : R;
        voffA[i] = (unsigned)(R * lda + C) * 2u; voffB[i] = (unsigned)(Rb * K + C) * 2u; }
    const size_t kstep = (size_t)(BK * 2);
    const size_t hstepA = (size_t)HALF * lda * 2, hstepB = (size_t)HALF * K * 2;
    const size_t tstepA = 2 * hstepA, tstepB = 2 * hstepB;
    const unsigned ldsw = (unsigned)wid * 1024u;
    const int aoff = lds_byte(wr * 64 + fr, fq * 8), boff = lds_byte(wc * 32 + fr, fq * 8);
#define PG8_SA(b, h) (((b) * 2 + (h)) * HTB)
#define PG8_SB(b, h) ((4 + (b) * 2 + (h)) * HTB)
#define PG8_STAGE(bufoff, gbase, voff) do { _Pragma("unroll") for (int _i = 0; _i < 2; ++_i) \
        __builtin_amdgcn_global_load_lds((const unsigned*)((const char*)(gbase) + (voff)[_i]), (PG8_LAS unsigned*)(lds + (bufoff) + ldsw + _i * 8192), 16, 0, 0); } while (0)
#define PG8_LDA(dst, b, h) do { _Pragma("unroll") for (int m = 0; m < 4; ++m) _Pragma("unroll") for (int k = 0; k < 2; ++k) dst[m][k] = *(const PG8_LAS bf16x8*)(lds + PG8_SA(b, h) + aoff + m * 2048 + k * 1024); } while (0)
#define PG8_LDB(dst, b, h) do { _Pragma("unroll") for (int n = 0; n < 2; ++n) _Pragma("unroll") for (int k = 0; k < 2; ++k) dst[n][k] = *(const PG8_LAS bf16x8*)(lds + PG8_SB(b, h) + boff + n * 2048 + k * 1024); } while (0)
#define PG8_MMA(ai, bj, At, Bt) do { __builtin_amdgcn_s_setprio(1); _Pragma("unroll") for (int m = 0; m < 4; ++m) _Pragma("unroll") for (int n = 0; n < 2; ++n) _Pragma("unroll") for (int k = 0; k < 2; ++k) \
        acc[ai][bj][m][n] = __builtin_amdgcn_mfma_f32_16x16x32_bf16(Bt[n][k], At[m][k], acc[ai][bj][m][n], 0, 0, 0); __builtin_amdgcn_s_setprio(0); } while (0)
#define PG8_WAIT_V(n) asm volatile("s_waitcnt vmcnt(" #n ")" ::: "memory")
#define PG8_WAIT_L(n) asm volatile("s_waitcnt lgkmcnt(" #n ")" ::: "memory")
#define PG8_BAR __builtin_amdgcn_s_barrier()
#define PG8_SCHED __builtin_amdgcn_sched_barrier(0)
    Unit cur, nxt; int ui = 0;
    if (!S.next(0, cur)) return;
    f32x4 acc[2][2][4][2];
#pragma unroll
    for (int a = 0; a < 2; ++a)
#pragma unroll
        for (int b = 0; b < 2; ++b)
#pragma unroll
            for (int m = 0; m < 4; ++m)
#pragma unroll
                for (int n = 0; n < 2; ++n) acc[a][b][m][n] = (f32x4){0.f, 0.f, 0.f, 0.f};
    bf16x8 At[4][2], B0[2][2], B1[2][2];
    const char* cA = (const char*)g.A + (size_t)cur.pm * tstepA; const char* cB = (const char*)g.Bt + (size_t)cur.pn * tstepB;
    PG8_STAGE(PG8_SB(0, 0), cB, voffB); PG8_STAGE(PG8_SA(0, 0), cA, voffA); PG8_STAGE(PG8_SB(0, 1), cB + hstepB, voffB); PG8_STAGE(PG8_SA(0, 1), cA + hstepA, voffA);
    if (wr == 1) PG8_BAR;
    PG8_WAIT_V(4); PG8_BAR;
    PG8_STAGE(PG8_SB(1, 0), cB + kstep, voffB); PG8_STAGE(PG8_SA(1, 0), cA + kstep, voffA); PG8_STAGE(PG8_SB(1, 1), cB + hstepB + kstep, voffB);
    PG8_WAIT_V(6); PG8_BAR;
    for (;;) {
        const bool has_next = S.next(ui + 1, nxt);
        const char* nA = has_next ? (const char*)g.A + (size_t)nxt.pm * tstepA : cA; const char* nB = has_next ? (const char*)g.Bt + (size_t)nxt.pn * tstepB : cB;
        for (int t = 0; t < nt; t += 2) {
            const bool last = (t == nt - 2);
            const char* a1 = cA + (size_t)(t + 1) * kstep;
            const char* a2 = last ? nA : cA + (size_t)(t + 2) * kstep; const char* b2 = last ? nB : cB + (size_t)(t + 2) * kstep;
            const char* a3 = a2 + kstep; const char* b3 = b2 + kstep;
            PG8_LDB(B0, 0, 0); PG8_SCHED; PG8_LDA(At, 0, 0); PG8_STAGE(PG8_SA(1, 1), a1 + hstepA, voffA);
            PG8_WAIT_L(8); PG8_BAR; PG8_WAIT_L(0); PG8_MMA(0, 0, At, B0); PG8_BAR; PG8_SCHED;
            PG8_LDB(B1, 0, 1); PG8_STAGE(PG8_SB(0, 0), b2, voffB);
            PG8_BAR; PG8_WAIT_L(0); PG8_MMA(0, 1, At, B1); PG8_BAR;
            PG8_LDA(At, 0, 1); PG8_STAGE(PG8_SA(0, 0), a2, voffA);
            PG8_BAR; PG8_WAIT_L(0); PG8_MMA(1, 0, At, B0); PG8_BAR; PG8_SCHED;
            PG8_STAGE(PG8_SB(0, 1), b2 + hstepB, voffB);
            PG8_WAIT_V(6); PG8_BAR; PG8_MMA(1, 1, At, B1); PG8_BAR;
            PG8_LDB(B0, 1, 0); PG8_SCHED; PG8_LDA(At, 1, 0); PG8_STAGE(PG8_SA(0, 1), a2 + hstepA, voffA);
            PG8_WAIT_L(8); PG8_BAR; PG8_WAIT_L(0); PG8_MMA(0, 0, At, B0); PG8_BAR; PG8_SCHED;
            PG8_LDB(B1, 1, 1); PG8_STAGE(PG8_SB(1, 0), b3, voffB);
            PG8_BAR; PG8_WAIT_L(0); PG8_MMA(0, 1, At, B1); PG8_BAR;
            PG8_LDA(At, 1, 1); PG8_STAGE(PG8_SA(1, 0), a3, voffA);
            PG8_BAR; PG8_WAIT_L(0); PG8_MMA(1, 0, At, B0); PG8_BAR; PG8_SCHED;
            PG8_STAGE(PG8_SB(1, 1), b3 + hstepB, voffB);
            PG8_WAIT_V(6); PG8_BAR; PG8_MMA(1, 1, At, B1); PG8_BAR;
        }
        E(acc, cur, wr, wc, fr, fq);
        if (!has_next) break;
#pragma unroll
        for (int a = 0; a < 2; ++a)
#pragma unroll
            for (int b = 0; b < 2; ++b)
#pragma unroll
                for (int m = 0; m < 4; ++m)
#pragma unroll
                    for (int n = 0; n < 2; ++n) acc[a][b][m][n] = (f32x4){0.f, 0.f, 0.f, 0.f};
        cur = nxt; cA = nA; cB = nB; ++ui;
    }
    PG8_WAIT_V(0);
    if (wr == 0) PG8_BAR;
    PG8_BAR;
#undef PG8_SA
#undef PG8_SB
#undef PG8_STAGE
#undef PG8_LDA
#undef PG8_LDB
#undef PG8_MMA
#undef PG8_WAIT_V
#undef PG8_WAIT_L
#undef PG8_BAR
#undef PG8_SCHED
}

struct EpiP {
    static constexpr bool PERM = true;
    bf16_t* P; float* G32;
    __device__ __forceinline__ void operator()(const f32x4 (&acc)[2][2][4][2], const Unit& u, int wr, int wc, int fr, int fq) const {
        const int row0 = u.pm * BM + wr * 64 + fr;
        if (u.pn < 37) {
            const int col0 = u.pn * BM + wc * 32 + 8 * fq;
#pragma unroll
            for (int ai = 0; ai < 2; ++ai)
#pragma unroll
                for (int m = 0; m < 4; ++m) { bf16_t* rowp = P + (size_t)(row0 + ai * HALF + m * 16) * LDP + col0;
#pragma unroll
                    for (int bj = 0; bj < 2; ++bj) { const f32x4 v0 = acc[ai][bj][m][0], v1 = acc[ai][bj][m][1];
                        u32x4 w; w.x = cvt_pk_bf16(v0[0], v0[1]); w.y = cvt_pk_bf16(v0[2], v0[3]); w.z = cvt_pk_bf16(v1[0], v1[1]); w.w = cvt_pk_bf16(v1[2], v1[3]);
                        *(u32x4*)(rowp + bj * HALF) = w; } }
        } else if (wc == 0 && fq < 2) {
#pragma unroll
            for (int ai = 0; ai < 2; ++ai)
#pragma unroll
                for (int m = 0; m < 4; ++m) { float* rowp = G32 + (size_t)(row0 + ai * HALF + m * 16) * 16 + 8 * fq;
                    *(f32x4*)(rowp) = acc[ai][0][m][0]; *(f32x4*)(rowp + 4) = acc[ai][0][m][1]; }
        }
    }
};
struct EpiRes {
    static constexpr bool PERM = true;
    const float* xp; const float* xs; const float* MOD; bf16_t* XN;
    __device__ __forceinline__ void operator()(const f32x4 (&acc)[2][2][4][2], const Unit& u, int wr, int wc, int fr, int fq) const {
        const int col0 = u.pn * BM + wc * 32 + 8 * fq;
        const int rid = row_rid(u.pm * BM);
        const float* x = (u.pm < 16) ? xp + (size_t)(u.pm * BM) * DM : xs + (size_t)(u.pm * BM - NPROMPT) * DM;
        f32x4 gv[2][2];
#pragma unroll
        for (int bj = 0; bj < 2; ++bj)
#pragma unroll
            for (int n = 0; n < 2; ++n) gv[bj][n] = *(const f32x4*)(MOD + (size_t)rid * 6144 + 4096 + col0 + bj * HALF + 4 * n);
        const float* xb = x + (size_t)(wr * 64 + fr) * DM + col0;
        bf16_t* ob = XN + (size_t)(u.pm * BM + wr * 64 + fr) * DM + col0;
        f32x4 xv[2][2][2][2];
#define EPI_LOAD(slot, q_) do { const int ai_ = (q_) >> 1, mp_ = (q_) & 1; \
            _Pragma("unroll") for (int mm = 0; mm < 2; ++mm) _Pragma("unroll") for (int bj = 0; bj < 2; ++bj) _Pragma("unroll") for (int n = 0; n < 2; ++n) \
                xv[slot][mm][bj][n] = *(const f32x4*)(xb + (size_t)(ai_ * HALF + (mp_ * 2 + mm) * 16) * DM + bj * HALF + 4 * n); } while (0)
        EPI_LOAD(0, 0);
#pragma unroll
        for (int q = 0; q < 4; ++q) {
            const int ai = q >> 1, mp = q & 1, cur = q & 1;
            if (q + 1 < 4) { if (cur == 0) EPI_LOAD(1, q + 1); else EPI_LOAD(0, q + 1); }
#pragma unroll
            for (int mm = 0; mm < 2; ++mm)
#pragma unroll
                for (int bj = 0; bj < 2; ++bj) {
                    const f32x4 v0 = xv[cur][mm][bj][0] + gv[bj][0] * acc[ai][bj][mp * 2 + mm][0], v1 = xv[cur][mm][bj][1] + gv[bj][1] * acc[ai][bj][mp * 2 + mm][1];
                    u32x4 w; w.x = pk2(v0[0], v0[1]); w.y = pk2(v0[2], v0[3]); w.z = pk2(v1[0], v1[1]); w.w = pk2(v1[2], v1[3]);
                    *(u32x4*)(ob + (size_t)(ai * HALF + (mp * 2 + mm) * 16) * DM + bj * HALF) = w;
                }
        }
#undef EPI_LOAD
    }
};
}

__device__ __forceinline__ void transpose_item(const float* W, int ldw, int srccol, bf16_t* WT, int K, int dst_n0, int k0, float* scr, int lane) {
    float tv[32];
#pragma unroll
    for (int i = 0; i < 32; ++i) { const int kk = 2 * i + (lane >> 5); tv[i] = srccol >= 0 ? W[(size_t)(k0 + kk) * ldw + srccol] : 0.f; }
#pragma unroll
    for (int i = 0; i < 32; ++i) { const int kk = 2 * i + (lane >> 5); scr[kk * 33 + (lane & 31)] = tv[i]; }
    asm volatile("s_waitcnt lgkmcnt(0)" ::: "memory");
    const int c = lane & 7;
#pragma unroll
    for (int j = 0; j < 4; ++j) { const int n = (lane >> 3) + 8 * j; const float* s = scr + (8 * c) * 33 + n;
        u32x4 o; o.x = pk2(s[0 * 33], s[1 * 33]); o.y = pk2(s[2 * 33], s[3 * 33]); o.z = pk2(s[4 * 33], s[5 * 33]); o.w = pk2(s[6 * 33], s[7 * 33]);
        *(u32x4*)(WT + (size_t)(dst_n0 + n) * K + k0 + 8 * c) = o; }
    asm volatile("s_waitcnt lgkmcnt(0)" ::: "memory");
}
__device__ __forceinline__ void phase0(const Params& p, unsigned char* lds) {
    const int tid = threadIdx.x, lane = tid & 63, wave = __builtin_amdgcn_readfirstlane(tid >> 6);
    float* sc = (float*)lds;
    float* scr = (float*)(lds + 73728) + wave * (64 * 33);
    for (int i = tid; i < 9 * 2048; i += 512) { const int r = i >> 11, k = i & 2047; const float v = r == 0 ? p.in[I_CCTX][k] : p.in[I_C][(r - 1) * 2048 + k]; sc[i] = silu_f(v); }
    __syncthreads();
    const int gw = blockIdx.x * 8 + wave, NGW = gridDim.x * 8;
    constexpr int I_GV = 192 * 8, I_IN = 32 * 297, I_OUT = 32 * 64;
    bf16_t* WinT = (bf16_t*)(p.ws + WS_WINT); bf16_t* WoutT = (bf16_t*)(p.ws + WS_WOUTT); float* MODP = (float*)(p.ws + WS_MODP);
    for (int it = gw; it < I_GV + I_IN + I_OUT; it += NGW) {
        if (it < I_GV) {
            const int ng = it % 192, kb = it / 192, col = ng * 32 + (lane & 31), kh = lane >> 5;
            float acc[9];
#pragma unroll
            for (int r = 0; r < 9; ++r) acc[r] = 0.f;
            const float* wp = p.in[I_WADA] + (size_t)(kb * 256 + kh) * 6144 + col;
#pragma unroll 16
            for (int i = 0; i < 128; ++i) { const float w = wp[(size_t)(2 * i) * 6144]; const int k = kb * 256 + 2 * i + kh;
#pragma unroll
                for (int r = 0; r < 9; ++r) acc[r] += sc[r * 2048 + k] * w; }
#pragma unroll
            for (int r = 0; r < 9; ++r) { acc[r] += __shfl_xor(acc[r], 32); if (lane < 32) MODP[(size_t)(kb * 9 + r) * 6144 + col] = acc[r]; }
        } else if (it < I_GV + I_IN) {
            const int j = it - I_GV, kb = j / 297, ng = j % 297, n = ng * 32 + (lane & 31);
            const int src = n < 5120 ? n : (n < 9472 ? n + 16 : (n < 9488 ? n - 9472 + 5120 : -1));
            transpose_item(p.in[I_WIN], 9488, src, WinT, 2048, ng * 32, kb * 64, scr, lane);
        } else {
            const int j = it - I_GV - I_IN, kb = j / 64, ng = j % 64;
            transpose_item(p.in[I_WOUT], 2048, ng * 32 + (lane & 31), WoutT, 2048, ng * 32, kb * 64, scr, lane);
        }
    }
}

__device__ __forceinline__ void phase1(const Params& p, unsigned char* lds) {
    const int tid = threadIdx.x, lane = tid & 63, wave = __builtin_amdgcn_readfirstlane(tid >> 6);
    const float* MODP = (const float*)(p.ws + WS_MODP); float* MOD = (float*)(p.ws + WS_MOD);
    const float* b_ada = p.in[I_BADA];
    for (int i = blockIdx.x * 512 + tid; i < 9 * 6144; i += gridDim.x * 512) { const int n = i % 6144; float s = b_ada[n];
#pragma unroll
        for (int kb = 0; kb < 8; ++kb) s += MODP[(size_t)kb * 9 * 6144 + i];
        MOD[i] = s; }
    float* A = (float*)lds; float* B = A + 4096;
    const int rpb = MROWS / gridDim.x, rowbase = blockIdx.x * rpb;
    const int r_lo = row_rid(rowbase), r_hi = row_rid(rowbase + rpb - 1);
    for (int idx = tid; idx < 4096; idx += 512) { const int which = idx >> 11, n = idx & 2047, r = which ? r_hi : r_lo;
        float sh = b_ada[n], scl = b_ada[2048 + n];
#pragma unroll
        for (int kb = 0; kb < 8; ++kb) { sh += MODP[(size_t)(kb * 9 + r) * 6144 + n]; scl += MODP[(size_t)(kb * 9 + r) * 6144 + 2048 + n]; }
        A[idx] = p.in[I_NORMG][n] * (1.f + scl); B[idx] = sh; }
    __syncthreads();
    bf16_t* H = (bf16_t*)((unsigned char*)p.out + Y_H);
    for (int row = rowbase + wave; row < rowbase + rpb; row += 8) {
        const float* x = row < NPROMPT ? p.in[I_XP] + (size_t)row * DM : p.in[I_XS] + (size_t)(row - NPROMPT) * DM;
        const int sel = (row_rid(row) == r_lo) ? 0 : 2048;
        f32x4 v[8]; float ss = 0.f;
#pragma unroll
        for (int j = 0; j < 8; ++j) { v[j] = *(const f32x4*)(x + 4 * lane + 256 * j); ss += (v[j].x * v[j].x + v[j].y * v[j].y) + (v[j].z * v[j].z + v[j].w * v[j].w); }
        const float rstd = rsqrtf(wave_sum(ss) * (1.f / DM) + EPS);
#pragma unroll
        for (int j = 0; j < 8; ++j) { const int c = 4 * lane + 256 * j; const f32x4 a = *(const f32x4*)(A + sel + c), b = *(const f32x4*)(B + sel + c);
            u32x2 o; o.x = pk2(v[j].x * rstd * a.x + b.x, v[j].y * rstd * a.y + b.y); o.y = pk2(v[j].z * rstd * a.z + b.z, v[j].w * rstd * a.w + b.w);
            *(u32x2*)(H + (size_t)row * DM + c) = o; }
    }
}

__device__ __forceinline__ float shift_mix(float x, float sh, float mu) { return x + mu * (sh - x); }
__device__ __forceinline__ float fast_tanh(float x) { return 1.f - 2.f * __builtin_amdgcn_rcpf(1.f + __expf(2.f * x)); }
__device__ __forceinline__ void phase_prep(const Params& p) {
    const int tid = threadIdx.x, lane = tid & 63, wave = __builtin_amdgcn_readfirstlane(tid >> 6);
    const bf16_t* P = (const bf16_t*)(p.ws + WS_P);
    bf16_t* QKC = (bf16_t*)(p.ws + WS_QKC); bf16_t* XL = (bf16_t*)(p.ws + WS_XL);
    const float* cw = p.in[I_CONVW]; const float* cb = p.in[I_CONVB];
    {
        const int o8 = (tid & 255) * 8, half = tid >> 8, rpb = MROWS / gridDim.x, rbeg = blockIdx.x * rpb + half * (rpb / 2), rend = rbeg + rpb / 2;
        const f32x4 w0a = *(const f32x4*)(cw + o8), w0b = *(const f32x4*)(cw + o8 + 4), w1a = *(const f32x4*)(cw + 2048 + o8), w1b = *(const f32x4*)(cw + 2052 + o8), w2a = *(const f32x4*)(cw + 4096 + o8), w2b = *(const f32x4*)(cw + 4100 + o8);
        const f32x4 ba = *(const f32x4*)(cb + o8), bb = *(const f32x4*)(cb + o8 + 4);
        const float sc = o8 >= 1024 ? 0.0625f : 1.f;
        const u32x4 zero = (u32x4){0u, 0u, 0u, 0u};
        u32x4 xm = rbeg > 0 ? *(const u32x4*)(P + (size_t)(rbeg - 1) * LDP + o8) : zero;
        u32x4 xc = *(const u32x4*)(P + (size_t)rbeg * LDP + o8);
#pragma unroll 1
        for (int rb = rbeg; rb < rend; rb += 8) {
            u32x4 xb[8];
#pragma unroll
            for (int i = 0; i < 8; ++i) xb[i] = (rb + i + 1 < MROWS) ? *(const u32x4*)(P + (size_t)(rb + i + 1) * LDP + o8) : zero;
#pragma unroll
            for (int i = 0; i < 8; ++i) {
                const int row = rb + i; const u32x4 xn = xb[i];
                const int T = row < NPROMPT ? TP : TS, tk = row < NPROMPT ? (row & 255) : ((row - NPROMPT) & 2047);
                const u32x4 x0 = tk > 0 ? xm : zero, x1 = xc, x2 = tk < T - 1 ? xn : zero;
                float o[8];
                o[0] = ba.x + w0a.x * bflo(x0.x) + w1a.x * bflo(x1.x) + w2a.x * bflo(x2.x);
                o[1] = ba.y + w0a.y * bfhi(x0.x) + w1a.y * bfhi(x1.x) + w2a.y * bfhi(x2.x);
                o[2] = ba.z + w0a.z * bflo(x0.y) + w1a.z * bflo(x1.y) + w2a.z * bflo(x2.y);
                o[3] = ba.w + w0a.w * bfhi(x0.y) + w1a.w * bfhi(x1.y) + w2a.w * bfhi(x2.y);
                o[4] = bb.x + w0b.x * bflo(x0.z) + w1b.x * bflo(x1.z) + w2b.x * bflo(x2.z);
                o[5] = bb.y + w0b.y * bfhi(x0.z) + w1b.y * bfhi(x1.z) + w2b.y * bfhi(x2.z);
                o[6] = bb.z + w0b.z * bflo(x0.w) + w1b.z * bflo(x1.w) + w2b.z * bflo(x2.w);
                o[7] = bb.w + w0b.w * bfhi(x0.w) + w1b.w * bfhi(x1.w) + w2b.w * bfhi(x2.w);
#pragma unroll
                for (int e = 0; e < 8; ++e) o[e] = silu_f(o[e]) * sc;
                u32x4 ov; ov.x = pk2(o[0], o[1]); ov.y = pk2(o[2], o[3]); ov.z = pk2(o[4], o[5]); ov.w = pk2(o[6], o[7]);
                *(u32x4*)(QKC + (size_t)row * 2048 + o8) = ov;
                xm = xc; xc = xn;
            }
        }
    }
    for (int row = blockIdx.x * 8 + wave; row < MROWS; row += gridDim.x * 8) {
        const bf16_t* prow = P + (size_t)row * LDP;
        {
            int n0, n1, n2, n3; bool k0, k1, k2, k3; nbrs(row, n0, n1, n2, n3, k0, k1, k2, k3);
            const int cl = 4 * lane; const u32x2 z2 = (u32x2){0u, 0u};
            const u32x2 own = *(const u32x2*)(prow + C_WD + cl);
            const u32x2 v0 = k0 ? *(const u32x2*)(P + (size_t)n0 * LDP + C_WD + cl) : z2, v1 = k1 ? *(const u32x2*)(P + (size_t)n1 * LDP + C_WD + cl) : z2;
            const u32x2 v2 = k2 ? *(const u32x2*)(P + (size_t)n2 * LDP + C_WD + cl) : z2, v3 = k3 ? *(const u32x2*)(P + (size_t)n3 * LDP + C_WD + cl) : z2;
            const f32x4 mu = *(const f32x4*)(p.in[I_RMU] + 3072 + cl);
            float a = bflo(own.x), b = bfhi(own.x), c = bflo(own.y), d = bfhi(own.y);
            a += mu.x * (bflo(v0.x) - a); b += mu.y * (bfhi(v1.x) - b); c += mu.z * (bflo(v2.y) - c); d += mu.w * (bfhi(v3.y) - d);
            if (lane < 32) { a = fast_tanh(a); b = fast_tanh(b); c = fast_tanh(c); d = fast_tanh(d); }
            u32x2 o; o.x = pk2(a, b); o.y = pk2(c, d);
            *(u32x2*)(XL + (size_t)row * 256 + cl) = o;
        }
    }
}

constexpr int RCH = 32;
typedef float f32x2 __attribute__((ext_vector_type(2)));
__device__ __forceinline__ float dpp_rowmirror(float v) { return __int_as_float(__builtin_amdgcn_update_dpp(0, __float_as_int(v), 0x140, 0xF, 0xF, true)); }
__device__ __forceinline__ float red16(float v) { v += dpp_f(v, 0); v += dpp_f(v, 1); v += dpp_f(v, 2); v += dpp_rowmirror(v); return v; }
struct RwkvRaw { u32x4 xl[2][2]; u32x2 own[3], nb[4][3]; };
template <int KS> __device__ __forceinline__ f32x4 tile_mm(const bf16_t* A, int pa, const bf16_t* B, int pb, int fr, int kg, f32x4 acc) {
#pragma unroll
    for (int kk = 0; kk < KS; ++kk) {
        const bf16x8 a = *(const bf16x8*)(A + fr * pa + kk * 32 + kg * 8), b = *(const bf16x8*)(B + fr * pb + kk * 32 + kg * 8);
        acc = __builtin_amdgcn_mfma_f32_16x16x32_bf16(a, b, acc, 0, 0, 0);
    }
    return acc;
}
__device__ __forceinline__ void store_nat(bf16_t* Z, int pz, int n0, int m0, int fr, int kg, f32x4 v, float zv) {
    v = v + zv;
    u32x2 o; o.x = pk2(v[0], v[1]); o.y = pk2(v[2], v[3]); *(u32x2*)(Z + (n0 + fr) * pz + m0 + kg * 4) = o;
}
constexpr int VP = 72, TP40 = 40;
__device__ void rwkv_chain(const Params& p, unsigned char* lds, int row0, int T, int z, int hd, const float* S0, float* Sout) {
    const int tid = threadIdx.x, lane = tid & 63, wave = __builtin_amdgcn_readfirstlane(tid >> 6);
    const bf16_t* P = (const bf16_t*)(p.ws + WS_P);
    const bf16_t* XL = (const bf16_t*)(p.ws + WS_XL);
    float* LW = (float*)lds;
    float* AA = LW + 2048;
    float* DL = AA + 2048;
    float* DEND = DL + 2048;
    bf16_t* ALb = (bf16_t*)(DEND + 64);
    bf16_t* RHb = ALb + 32 * VP;
    bf16_t* BEb = RHb + 32 * VP;
    bf16_t* KAb = BEb + 32 * VP;
    bf16_t* BET = KAb + 32 * VP;
    bf16_t* KAT = BET + 64 * TP40;
    bf16_t* VVT = KAT + 64 * TP40;
    bf16_t* Sb = VVT + 64 * TP40;
    bf16_t* NDg = Sb + 64 * VP;
    bf16_t* NDt = NDg + 4 * 16 * TP40;
    bf16_t* HD = NDt + 4 * 16 * TP40;
    bf16_t* N12T = HD + 4 * 16 * TP40;
    bf16_t* HH = N12T + 16 * TP40;
    bf16_t* TKT = HH + 32 * TP40;
    bf16_t* PBT = TKT + 32 * TP40;
    bf16_t* PKT = PBT + 32 * TP40;
    bf16_t* Wb = PKT + 32 * TP40;
    bf16_t* Ub = Wb + 64 * TP40;
    const float zv = opaque_zero();
    bf16_t* Yout = (bf16_t*)((unsigned char*)p.out + (z ? Y_YB : Y_YF));
    float* BON = (float*)(p.ws + WS_BON) + (size_t)z * MROWS * 16;
    const int type = wave >> 2, tile = wave & 3, fr = lane & 15, kg = lane >> 4;
    bf16x8 Bfrag[2];
    {
        const float* W2 = (type ? p.in[I_RA2] : p.in[I_RW2]) + (size_t)z * 64 * 1024 + hd * 64 + tile * 16 + fr;
#pragma unroll
        for (int kk = 0; kk < 2; ++kk) {
            float w[8];
#pragma unroll
            for (int j = 0; j < 8; ++j) w[j] = W2[(size_t)(kk * 32 + kg * 8 + j) * 1024];
            u32x4 t; t.x = pk2(w[0], w[1]); t.y = pk2(w[2], w[3]); t.z = pk2(w[4], w[5]); t.w = pk2(w[6], w[7]);
            Bfrag[kk] = __builtin_bit_cast(bf16x8, t);
        }
    }
    const int ccA = tile * 16 + fr;
    const float biasA = type ? p.in[I_RA0][z * 1024 + hd * 64 + ccA] : p.in[I_RW0][z * 1024 + hd * 64 + ccA];
    const int pB = tid >> 4, c4 = 4 * (tid & 15), cB = hd * 64 + c4;
    const f32x4 mur = *(const f32x4*)(p.in[I_RMU] + cB), muk = *(const f32x4*)(p.in[I_RMU] + 1024 + cB), muv = *(const f32x4*)(p.in[I_RMU] + 2048 + cB);
    const f32x4 kkc = *(const f32x4*)(p.in[I_RKK] + cB), kac = *(const f32x4*)(p.in[I_RKA] + cB), rkc = *(const f32x4*)(p.in[I_RRK] + cB);
    const int jt = wave >> 1, it0 = (wave & 1) * 2;
    f32x4 sacc[2];
#pragma unroll
    for (int a = 0; a < 2; ++a) {
        const int i = (it0 + a) * 16 + fr, j = jt * 16 + kg * 4;
        sacc[a] = S0 ? *(const f32x4*)(S0 + (size_t)i * 64 + j) : (f32x4){0.f, 0.f, 0.f, 0.f};
        u32x2 o; o.x = pk2(sacc[a][0], sacc[a][1]); o.y = pk2(sacc[a][2], sacc[a][3]); *(u32x2*)(Sb + i * VP + j) = o;
    }

    for (int i = tid; i < (int)((Ub + 64 * TP40) - NDg) / 2; i += 512) ((unsigned*)NDg)[i] = 0u;
    RwkvRaw raw;
#define RW_LOAD(s0_) do { \
        _Pragma("unroll") for (int tt = 0; tt < 2; ++tt) { const int tkA = z ? (T - 1 - ((s0_) + tt * 16 + fr)) : ((s0_) + tt * 16 + fr); \
            const bf16_t* xr = XL + (size_t)(row0 + tkA) * 256 + type * 128 + z * 64 + kg * 8; \
            raw.xl[tt][0] = *(const u32x4*)(xr); raw.xl[tt][1] = *(const u32x4*)(xr + 32); } \
        const int tkL = z ? (T - 1 - ((s0_) + pB)) : ((s0_) + pB), rowL = row0 + tkL; \
        int n_[4]; bool k_[4]; nbrs(rowL, n_[0], n_[1], n_[2], n_[3], k_[0], k_[1], k_[2], k_[3]); \
        const bf16_t* pr = P + (size_t)rowL * LDP + cB; \
        raw.own[0] = *(const u32x2*)(pr + C_RR); raw.own[1] = *(const u32x2*)(pr + C_RK); raw.own[2] = *(const u32x2*)(pr + C_RV); \
        _Pragma("unroll") for (int g = 0; g < 4; ++g) { const bf16_t* pn = P + (size_t)n_[g] * LDP + cB; const u32x2 z2 = (u32x2){0u, 0u}; \
            raw.nb[g][0] = k_[g] ? *(const u32x2*)(pn + C_RR) : z2; raw.nb[g][1] = k_[g] ? *(const u32x2*)(pn + C_RK) : z2; raw.nb[g][2] = k_[g] ? *(const u32x2*)(pn + C_RV) : z2; } \
    } while (0)

    RW_LOAD(0);
    {
        {
            float lwv[2][4];
#pragma unroll
            for (int tt = 0; tt < 2; ++tt) {
                f32x4 acc = (f32x4){0.f, 0.f, 0.f, 0.f};
                acc = __builtin_amdgcn_mfma_f32_16x16x32_bf16(__builtin_bit_cast(bf16x8, raw.xl[tt][0]), Bfrag[0], acc, 0, 0, 0);
                acc = __builtin_amdgcn_mfma_f32_16x16x32_bf16(__builtin_bit_cast(bf16x8, raw.xl[tt][1]), Bfrag[1], acc, 0, 0, 0);
#pragma unroll
                for (int j = 0; j < 4; ++j) { const int pp = tt * 16 + kg * 4 + j; const float x = biasA + acc[j];
                    if (type == 0) { const float lw = -0.60653066f * __builtin_amdgcn_rcpf(1.f + __expf(-x)); lwv[tt][j] = lw; LW[pp * 64 + ccA] = lw; }
                    else { lwv[tt][j] = 0.f; AA[pp * 64 + ccA] = __builtin_amdgcn_rcpf(1.f + __expf(-x)); } }
            }
            if (type == 0) { float carry = 0.f;
#pragma unroll
                for (int tt = 0; tt < 2; ++tt) {
                    const float p0 = lwv[tt][0], p1 = p0 + lwv[tt][1], p2 = p1 + lwv[tt][2], p3 = p2 + lwv[tt][3];
                    float inc = p3; const float t1 = __shfl_up(inc, 16); if (lane >= 16) inc += t1; const float t2 = __shfl_up(inc, 32); if (lane >= 32) inc += t2;
                    const float ex = inc - p3 + carry; const int pp = tt * 16 + kg * 4;
                    DL[(pp + 0) * 64 + ccA] = ex + p0; DL[(pp + 1) * 64 + ccA] = ex + p1; DL[(pp + 2) * 64 + ccA] = ex + p2; DL[(pp + 3) * 64 + ccA] = ex + p3;
                    carry += __shfl(inc, 48 + fr); } }
        }
    }
    __syncthreads();
    for (int s0 = 0; s0 < T; s0 += RCH) {
        {
            const int tkB = z ? (T - 1 - (s0 + pB)) : (s0 + pB), rowB = row0 + tkB;
            f32x4 rs, ks, vs;
            rs.x = shift_mix(bflo(raw.own[0].x), bflo(raw.nb[0][0].x), mur.x); rs.y = shift_mix(bfhi(raw.own[0].x), bfhi(raw.nb[1][0].x), mur.y);
            rs.z = shift_mix(bflo(raw.own[0].y), bflo(raw.nb[2][0].y), mur.z); rs.w = shift_mix(bfhi(raw.own[0].y), bfhi(raw.nb[3][0].y), mur.w);
            ks.x = shift_mix(bflo(raw.own[1].x), bflo(raw.nb[0][1].x), muk.x); ks.y = shift_mix(bfhi(raw.own[1].x), bfhi(raw.nb[1][1].x), muk.y);
            ks.z = shift_mix(bflo(raw.own[1].y), bflo(raw.nb[2][1].y), muk.z); ks.w = shift_mix(bfhi(raw.own[1].y), bfhi(raw.nb[3][1].y), muk.w);
            vs.x = shift_mix(bflo(raw.own[2].x), bflo(raw.nb[0][2].x), muv.x); vs.y = shift_mix(bfhi(raw.own[2].x), bfhi(raw.nb[1][2].x), muv.y);
            vs.z = shift_mix(bflo(raw.own[2].y), bflo(raw.nb[2][2].y), muv.z); vs.w = shift_mix(bfhi(raw.own[2].y), bfhi(raw.nb[3][2].y), muv.w);
            f32x4 kk = ks * kkc;
            const float nn = red16((kk.x * kk.x + kk.y * kk.y) + (kk.z * kk.z + kk.w * kk.w));
            kk = kk * fminf(__builtin_amdgcn_rsqf(nn), 1e12f);
            const f32x4 a = *(const f32x4*)(AA + pB * 64 + c4), lw = *(const f32x4*)(LW + pB * 64 + c4), dl = *(const f32x4*)(DL + pB * 64 + c4);
            const f32x4 bv = kk * a; const f32x4 kz = ks * (1.f + (a - 1.f) * kac);
            const f32x4 t1_ = rs * kz;
            const float bon = red16((t1_.x * rkc.x + t1_.y * rkc.y) + (t1_.z * rkc.z + t1_.w * rkc.w));
            f32x4 eD, eP, iD;
            eD.x = __expf(dl.x); eD.y = __expf(dl.y); eD.z = __expf(dl.z); eD.w = __expf(dl.w);
            eP.x = __expf(dl.x - lw.x); eP.y = __expf(dl.y - lw.y); eP.z = __expf(dl.z - lw.z); eP.w = __expf(dl.w - lw.w);
            iD.x = __expf(-dl.x); iD.y = __expf(-dl.y); iD.z = __expf(-dl.z); iD.w = __expf(-dl.w);
            const f32x4 al = -(kk * eP), rh = rs * eD, be = bv * iD, ka = kz * iD;
            u32x2 o;
            o.x = pk2(al.x, al.y); o.y = pk2(al.z, al.w); *(u32x2*)(ALb + pB * VP + c4) = o;
            o.x = pk2(rh.x, rh.y); o.y = pk2(rh.z, rh.w); *(u32x2*)(RHb + pB * VP + c4) = o;
            o.x = pk2(be.x, be.y); o.y = pk2(be.z, be.w); *(u32x2*)(BEb + pB * VP + c4) = o;
            o.x = pk2(ka.x, ka.y); o.y = pk2(ka.z, ka.w); *(u32x2*)(KAb + pB * VP + c4) = o;
            { const unsigned b0 = pk2(be.x, be.y), b1 = pk2(be.z, be.w), k0_ = pk2(ka.x, ka.y), k1_ = pk2(ka.z, ka.w), v0_ = pk2(vs.x, vs.y), v1_ = pk2(vs.z, vs.w);
              BET[(c4 + 0) * TP40 + pB] = (bf16_t)b0; BET[(c4 + 1) * TP40 + pB] = (bf16_t)(b0 >> 16); BET[(c4 + 2) * TP40 + pB] = (bf16_t)b1; BET[(c4 + 3) * TP40 + pB] = (bf16_t)(b1 >> 16);
              KAT[(c4 + 0) * TP40 + pB] = (bf16_t)k0_; KAT[(c4 + 1) * TP40 + pB] = (bf16_t)(k0_ >> 16); KAT[(c4 + 2) * TP40 + pB] = (bf16_t)k1_; KAT[(c4 + 3) * TP40 + pB] = (bf16_t)(k1_ >> 16);
              VVT[(c4 + 0) * TP40 + pB] = (bf16_t)v0_; VVT[(c4 + 1) * TP40 + pB] = (bf16_t)(v0_ >> 16); VVT[(c4 + 2) * TP40 + pB] = (bf16_t)v1_; VVT[(c4 + 3) * TP40 + pB] = (bf16_t)(v1_ >> 16); }
            if ((tid & 15) == 0) BON[(size_t)rowB * 16 + hd] = bon;
            if (z == 0) { u32x2 ov; ov.x = pk2(vs.x, vs.y); ov.y = pk2(vs.z, vs.w); *(u32x2*)(const_cast<bf16_t*>(P) + (size_t)rowB * LDP + C_MQ + cB) = ov; }
            if (pB == RCH - 1) *(f32x4*)(DEND + c4) = eD;
        }
        if (s0 + RCH < T) RW_LOAD(s0 + RCH);
        __syncthreads();
#pragma unroll
        for (int qi = 0; qi < 2; ++qi) {
            const int q = wave + 8 * qi; if (q >= 14) break;
            int grp, mt, nt;
            if (q < 3) { grp = 0; mt = (q == 1) ? 1 : 0; nt = (q == 0) ? 0 : 1; }
            else if (q < 5) { grp = 1; mt = nt = q - 3; }
            else { const int r = (q - 5) % 3; grp = 2 + (q - 5) / 3; mt = (r == 2) ? 1 : 0; nt = (r == 0) ? 0 : 1; }
            const bf16_t* Aop = (grp == 0 || grp == 3) ? BEb : (grp == 1 ? ALb : KAb);
            const bf16_t* Bop = (grp == 1) ? BEb : (grp >= 3 ? RHb : ALb);
            f32x4 d = tile_mm<2>(Aop + mt * 16 * VP, VP, Bop + nt * 16 * VP, VP, fr, kg, (f32x4){0.f, 0.f, 0.f, 0.f});
            const int n = nt * 16 + fr, m0 = mt * 16 + kg * 4;
            f32x4 h = d;
#pragma unroll
            for (int j = 0; j < 4; ++j) { const int m = m0 + j;
                const bool keep = (grp == 1) ? (n < m) : ((grp >= 3) ? (m <= n) : (m < n));
                d[j] = keep ? d[j] : 0.f; h[j] = d[j] + ((m == n) ? 1.f : 0.f); }
            if (grp == 0) {
                if (mt == nt) { store_nat(NDt + mt * 16 * TP40, TP40, 0, 0, fr, kg, d, zv); store_nat(HD + mt * 16 * TP40, TP40, 0, 0, fr, kg, h, zv); }
                else store_nat(N12T, TP40, 0, 0, fr, kg, d, zv);
            } else if (grp == 1) store_nat(NDg + mt * 16 * TP40, TP40, 0, 0, fr, kg, d, zv);
            else store_nat(grp == 2 ? TKT : (grp == 3 ? PBT : PKT), TP40, nt * 16, mt * 16, fr, kg, d, zv);
        }
        __syncthreads();
        const int tt = wave >> 2, itw = wave & 3;
        {
            f32x4 d = tile_mm<2>(ALb + tt * 16 * VP, VP, Sb + itw * 16 * VP, VP, fr, kg, (f32x4){0.f, 0.f, 0.f, 0.f});
            d = tile_mm<1>(TKT + tt * 16 * TP40, TP40, VVT + itw * 16 * TP40, TP40, fr, kg, d);
            store_nat(Wb, TP40, itw * 16, tt * 16, fr, kg, d, zv);
        }
        if (wave < 2) {
            const int blk = wave;
#define ND_G(buf) (NDg + ((buf) * 2 + blk) * 16 * TP40)
#define ND_T(buf) (NDt + ((buf) * 2 + blk) * 16 * TP40)
#define HD_(buf) (HD + ((buf) * 2 + blk) * 16 * TP40)
#define LWAIT() asm volatile("s_waitcnt lgkmcnt(0)" ::: "memory")
            const f32x4 zf = (f32x4){0.f, 0.f, 0.f, 0.f};
#pragma unroll
            for (int st = 1; st <= 4; ++st) {
                const int cur = (st - 1) & 1, nxt = st & 1;
                LWAIT();
                if (st >= 2) {
                    const bf16_t* Ho = HD_(st & 1);
                    f32x4 d = tile_mm<1>(ND_G(cur), TP40, Ho, TP40, fr, kg, zf);
                    const u32x2 ho = *(const u32x2*)(Ho + fr * TP40 + kg * 4);
                    d[0] += bflo(ho.x); d[1] += bfhi(ho.x); d[2] += bflo(ho.y); d[3] += bfhi(ho.y);
                    if (st < 4) store_nat(HD_((st + 1) & 1), TP40, 0, 0, fr, kg, d, zv);
                    else store_nat(HH, TP40, blk * 16, blk * 16, fr, kg, d, zv);
                }
                if (st <= 3) {
                    const f32x4 dg = tile_mm<1>(ND_T(cur), TP40, ND_G(cur), TP40, fr, kg, zf);
                    const f32x4 dt = tile_mm<1>(ND_G(cur), TP40, ND_T(cur), TP40, fr, kg, zf);
                    store_nat(ND_G(nxt), TP40, 0, 0, fr, kg, dg, zv); store_nat(ND_T(nxt), TP40, 0, 0, fr, kg, dt, zv);
                }
            }
#undef ND_G
#undef ND_T
#undef HD_
        }
        __syncthreads();
        if (wave < 4) {
            const int it = wave;
            const f32x4 zf = (f32x4){0.f, 0.f, 0.f, 0.f};
            f32x4 d = tile_mm<1>(HH, TP40, Wb + it * 16 * TP40, TP40, fr, kg, zf);
            store_nat(Ub, TP40, it * 16, 0, fr, kg, d, zv);
            LWAIT();
            d = tile_mm<1>(N12T, TP40, Ub + it * 16 * TP40, TP40, fr, kg, zf);
            { const u32x2 wo = *(const u32x2*)(Wb + (it * 16 + fr) * TP40 + 16 + kg * 4);
              d[0] += bflo(wo.x); d[1] += bfhi(wo.x); d[2] += bflo(wo.y); d[3] += bfhi(wo.y); }
            store_nat(Wb, TP40, it * 16, 16, fr, kg, d, zv);
            LWAIT();
            d = tile_mm<1>(HH + 16 * TP40, TP40, Wb + it * 16 * TP40, TP40, fr, kg, zf);
            store_nat(Ub, TP40, it * 16, 16, fr, kg, d, zv);
        }
#undef LWAIT
        __syncthreads();
        {
            f32x4 d = tile_mm<2>(RHb + tt * 16 * VP, VP, Sb + itw * 16 * VP, VP, fr, kg, (f32x4){0.f, 0.f, 0.f, 0.f});
            d = tile_mm<1>(PBT + tt * 16 * TP40, TP40, Ub + itw * 16 * TP40, TP40, fr, kg, d);
            d = tile_mm<1>(PKT + tt * 16 * TP40, TP40, VVT + itw * 16 * TP40, TP40, fr, kg, d);
#pragma unroll
            for (int j = 0; j < 4; ++j) { const int t = tt * 16 + kg * 4 + j, tk = z ? (T - 1 - (s0 + t)) : (s0 + t);
                Yout[(size_t)(row0 + tk) * 1024 + hd * 64 + itw * 16 + fr] = (bf16_t)pk2(d[j] + zv, 0.f); }
        }
        const f32x4 dend = *(const f32x4*)(DEND + jt * 16 + kg * 4);
#pragma unroll
        for (int a = 0; a < 2; ++a) {
            f32x4 c = tile_mm<1>(BET + jt * 16 * TP40, TP40, Ub + (it0 + a) * 16 * TP40, TP40, fr, kg, sacc[a]);
            c = tile_mm<1>(KAT + jt * 16 * TP40, TP40, VVT + (it0 + a) * 16 * TP40, TP40, fr, kg, c);
            sacc[a] = c * dend;
        }
        if (s0 + RCH < T) {
        {
            float lwv[2][4];
#pragma unroll
            for (int tt = 0; tt < 2; ++tt) {
                f32x4 acc = (f32x4){0.f, 0.f, 0.f, 0.f};
                acc = __builtin_amdgcn_mfma_f32_16x16x32_bf16(__builtin_bit_cast(bf16x8, raw.xl[tt][0]), Bfrag[0], acc, 0, 0, 0);
                acc = __builtin_amdgcn_mfma_f32_16x16x32_bf16(__builtin_bit_cast(bf16x8, raw.xl[tt][1]), Bfrag[1], acc, 0, 0, 0);
#pragma unroll
                for (int j = 0; j < 4; ++j) { const int pp = tt * 16 + kg * 4 + j; const float x = biasA + acc[j];
                    if (type == 0) { const float lw = -0.60653066f * __builtin_amdgcn_rcpf(1.f + __expf(-x)); lwv[tt][j] = lw; LW[pp * 64 + ccA] = lw; }
                    else { lwv[tt][j] = 0.f; AA[pp * 64 + ccA] = __builtin_amdgcn_rcpf(1.f + __expf(-x)); } }
            }
            if (type == 0) { float carry = 0.f;
#pragma unroll
                for (int tt = 0; tt < 2; ++tt) {
                    const float p0 = lwv[tt][0], p1 = p0 + lwv[tt][1], p2 = p1 + lwv[tt][2], p3 = p2 + lwv[tt][3];
                    float inc = p3; const float t1 = __shfl_up(inc, 16); if (lane >= 16) inc += t1; const float t2 = __shfl_up(inc, 32); if (lane >= 32) inc += t2;
                    const float ex = inc - p3 + carry; const int pp = tt * 16 + kg * 4;
                    DL[(pp + 0) * 64 + ccA] = ex + p0; DL[(pp + 1) * 64 + ccA] = ex + p1; DL[(pp + 2) * 64 + ccA] = ex + p2; DL[(pp + 3) * 64 + ccA] = ex + p3;
                    carry += __shfl(inc, 48 + fr); } }
        }
        }
        __syncthreads();
#pragma unroll
        for (int a = 0; a < 2; ++a) { const int i = (it0 + a) * 16 + fr, j = jt * 16 + kg * 4;
            u32x2 o; o.x = pk2(sacc[a][0], sacc[a][1]); o.y = pk2(sacc[a][2], sacc[a][3]); *(u32x2*)(Sb + i * VP + j) = o; }
    }
#undef RW_LOAD
    if (Sout) {
#pragma unroll
        for (int a = 0; a < 2; ++a) { const int i = (it0 + a) * 16 + fr, j = jt * 16 + kg * 4; *(f32x4*)(Sout + (size_t)i * 64 + j) = sacc[a]; }
    }
    __syncthreads();
}

constexpr int QS = 264, TS72 = 72;
__device__ void mlstm_unit(const Params& p, unsigned char* lds, int row0, int T, int z, int hd, int es,
                           const float* C0, const float* n0, const float* m0p, float* Cout, float* nout, float* mout) {
    const int tid = threadIdx.x, lane = tid & 63, wave = __builtin_amdgcn_readfirstlane(tid >> 6), fr = lane & 15, kg = lane >> 4;
    const bf16_t* P = (const bf16_t*)(p.ws + WS_P);
    const float* G32 = (const float*)(p.ws + WS_G32);
    bf16_t* Q = (bf16_t*)lds;
    bf16_t* Kc = Q + 64 * QS;
    bf16_t* CT = Kc + 64 * QS;
    bf16_t* NVb = CT + 64 * QS;
    bf16_t* WKT = NVb + QS;
    bf16_t* VT = WKT + 256 * TS72;
    bf16_t* AM = VT + 64 * TS72;
    float* NV = (float*)(AM + 64 * TS72);
    float* BB = NV + 256; float* IB = BB + 64; float* MT = IB + 64; float* SIN = MT + 64; float* WF = SIN + 64; float* HD = WF + 64; float* SCAL = HD + 64;
    bf16_t* ONES = (bf16_t*)(SCAL + 4);
    bf16_t* Hout = (bf16_t*)((unsigned char*)p.out + (z ? Y_HB : Y_HF));
    const bf16_t* QKC = (const bf16_t*)(p.ws + WS_QKC);
    const float zvm = opaque_zero();
    const int d8 = tid & 31, pg = tid >> 5;
    const float gbi = p.in[I_GATEB][z * 8 + hd], gbf = p.in[I_GATEB][z * 8 + 4 + hd];
    const int vp = tid >> 3, ve8 = (tid & 7) * 8;
    u32x4 pq[4], pk[4], pv; float pgi = 0.f, pgf = 0.f;
#define ML_LOAD(s0_) do { \
        _Pragma("unroll") for (int i = 0; i < 4; ++i) { const int pp_ = pg + 16 * i, tk_ = z ? (T - 1 - ((s0_) + pp_)) : ((s0_) + pp_); \
            const bf16_t* qr = QKC + (size_t)(row0 + tk_) * 2048 + hd * 256 + d8 * 8; pq[i] = *(const u32x4*)qr; pk[i] = *(const u32x4*)(qr + 1024); } \
        { const int tk_ = z ? (T - 1 - ((s0_) + vp)) : ((s0_) + vp); pv = *(const u32x4*)(P + (size_t)(row0 + tk_) * LDP + C_MV + hd * 256 + es * 64 + ve8); } \
        if (wave == 0) { const int tk_ = z ? (T - 1 - ((s0_) + lane)) : ((s0_) + lane); const float* gr = G32 + (size_t)(row0 + tk_) * 16 + z * 8 + hd; pgi = gr[0]; pgf = gr[4]; } \
    } while (0)
    f32x4 cacc[2][4];
#pragma unroll
    for (int a = 0; a < 2; ++a)
#pragma unroll
        for (int et = 0; et < 4; ++et) {
#pragma unroll
            for (int j = 0; j < 4; ++j) { const int d = (2 * wave + a) * 16 + kg * 4 + j, e = et * 16 + fr;
                cacc[a][et][j] = C0 ? C0[(size_t)d * 256 + es * 64 + e] : 0.f; }
            const int d = (2 * wave + a) * 16 + kg * 4, e = et * 16 + fr;
            u32x2 o; o.x = pk2(cacc[a][et][0], cacc[a][et][1]); o.y = pk2(cacc[a][et][2], cacc[a][et][3]);
            *(u32x2*)(CT + e * QS + d) = o;
        }
    if (tid < 256) { const float nv0 = n0 ? n0[tid] : 0.f; NV[tid] = nv0; NVb[tid] = (bf16_t)pk2(nv0, 0.f); }
    if (tid < 8) NVb[256 + tid] = (bf16_t)0u;
    for (int i = tid; i < 16 * TS72; i += 512) ONES[i] = (bf16_t)((i < 64) ? 0x3F80u : 0u);
    float m = m0p ? m0p[0] : -INFINITY;
    ML_LOAD(0);
    __syncthreads();

    for (int s0 = 0; s0 < T; s0 += 64) {
        if (wave == 0) {
            const float ig = pgi + gbi;
            const float fpre = pgf + gbf;
            const float fg = -(fmaxf(-fpre, 0.f) + (__builtin_amdgcn_logf(1.f + __expf(-fabsf(fpre))) * 0.69314718f));
            const float b = wave_scan_add(fg);
            const float ib = ig - b; const float cm = wave_scan_max(ib);
            const float bL = lane63(b);
            const float mt = b + fmaxf(m, cm);
            const float g = bL + ib; const float gmax = lane63(cm) + bL;
            const float m_new = fmaxf(bL + m, gmax);
            BB[lane] = b; IB[lane] = ib; MT[lane] = mt; SIN[lane] = __expf(b + m - mt); WF[lane] = __expf(g - m_new);
            if (lane == 0) { SCAL[0] = __expf(bL + m - m_new); SCAL[1] = m_new; }
        }
#pragma unroll
        for (int i = 0; i < 4; ++i) { const int pp = pg + 16 * i; *(u32x4*)(Q + pp * QS + d8 * 8) = pq[i]; *(u32x4*)(Kc + pp * QS + d8 * 8) = pk[i]; }
        VT[(ve8 + 0) * TS72 + vp] = (bf16_t)(pv.x & 0xffffu); VT[(ve8 + 1) * TS72 + vp] = (bf16_t)(pv.x >> 16);
        VT[(ve8 + 2) * TS72 + vp] = (bf16_t)(pv.y & 0xffffu); VT[(ve8 + 3) * TS72 + vp] = (bf16_t)(pv.y >> 16);
        VT[(ve8 + 4) * TS72 + vp] = (bf16_t)(pv.z & 0xffffu); VT[(ve8 + 5) * TS72 + vp] = (bf16_t)(pv.z >> 16);
        VT[(ve8 + 6) * TS72 + vp] = (bf16_t)(pv.w & 0xffffu); VT[(ve8 + 7) * TS72 + vp] = (bf16_t)(pv.w >> 16);
        __syncthreads();
        if (s0 + 64 < T) ML_LOAD(s0 + 64);
        {
            const int d = tid & 255, ph = tid >> 8;
#pragma unroll
            for (int i = 0; i < 4; ++i) { const int po = ph * 4 + i; float w[8];
#pragma unroll
                for (int j = 0; j < 8; ++j) w[j] = WF[po * 8 + j] * bf2f((unsigned)Kc[(po * 8 + j) * QS + d]);
                u32x4 o; o.x = pk2(w[0], w[1]); o.y = pk2(w[2], w[3]); o.z = pk2(w[4], w[5]); o.w = pk2(w[6], w[7]);
                *(u32x4*)(WKT + d * TS72 + po * 8) = o; }
        }
        {
            const int tr = wave >> 1, tc0 = (wave & 1) * 2;
            f32x4 a0 = (f32x4){0.f, 0.f, 0.f, 0.f}, a1 = a0;
#pragma unroll
            for (int kk = 0; kk < 8; ++kk) {
                const bf16x8 af = *(const bf16x8*)(Q + (tr * 16 + fr) * QS + kk * 32 + kg * 8);
                const bf16x8 b0 = *(const bf16x8*)(Kc + (tc0 * 16 + fr) * QS + kk * 32 + kg * 8);
                const bf16x8 b1 = *(const bf16x8*)(Kc + ((tc0 + 1) * 16 + fr) * QS + kk * 32 + kg * 8);
                a0 = __builtin_amdgcn_mfma_f32_16x16x32_bf16(af, b0, a0, 0, 0, 0);
                a1 = __builtin_amdgcn_mfma_f32_16x16x32_bf16(af, b1, a1, 0, 0, 0);
            }
#pragma unroll
            for (int j = 0; j < 4; ++j) { const int t = tr * 16 + kg * 4 + j; const float bt = BB[t] - MT[t];
                { const int s = tc0 * 16 + fr; const float w = __expf(fminf(bt + IB[s], 0.f)) * ((s <= t) ? a0[j] : 0.f); AM[t * TS72 + s] = (bf16_t)pk2(w, w); }
                { const int s = (tc0 + 1) * 16 + fr; const float w = __expf(fminf(bt + IB[s], 0.f)) * ((s <= t) ? a1[j] : 0.f); AM[t * TS72 + s] = (bf16_t)pk2(w, w); } }
        }
        __syncthreads();
        f32x4 X0, X1, Y0, Y1;
        const int tr3 = wave >> 1, te0 = (wave & 1) * 2;
        {
            X0 = (f32x4){0.f, 0.f, 0.f, 0.f}; X1 = X0; Y0 = X0; Y1 = X0;
            f32x4 QN = X0, AS = X0;
            const bool dw = (te0 == 0);
#pragma unroll
            for (int kk = 0; kk < 8; ++kk) {
                const bf16x8 af = *(const bf16x8*)(Q + (tr3 * 16 + fr) * QS + kk * 32 + kg * 8);
                const bf16x8 b0 = *(const bf16x8*)(CT + (te0 * 16 + fr) * QS + kk * 32 + kg * 8);
                const bf16x8 b1 = *(const bf16x8*)(CT + ((te0 + 1) * 16 + fr) * QS + kk * 32 + kg * 8);
                X0 = __builtin_amdgcn_mfma_f32_16x16x32_bf16(af, b0, X0, 0, 0, 0);
                X1 = __builtin_amdgcn_mfma_f32_16x16x32_bf16(af, b1, X1, 0, 0, 0);
                if (dw) { const bf16x8 bn = *(const bf16x8*)(CT + (64 + fr) * QS + kk * 32 + kg * 8); QN = __builtin_amdgcn_mfma_f32_16x16x32_bf16(af, bn, QN, 0, 0, 0); }
            }
#pragma unroll
            for (int kk = 0; kk < 2; ++kk) {
                const bf16x8 af = *(const bf16x8*)(AM + (tr3 * 16 + fr) * TS72 + kk * 32 + kg * 8);
                const bf16x8 b0 = *(const bf16x8*)(VT + (te0 * 16 + fr) * TS72 + kk * 32 + kg * 8);
                const bf16x8 b1 = *(const bf16x8*)(VT + ((te0 + 1) * 16 + fr) * TS72 + kk * 32 + kg * 8);
                Y0 = __builtin_amdgcn_mfma_f32_16x16x32_bf16(af, b0, Y0, 0, 0, 0);
                Y1 = __builtin_amdgcn_mfma_f32_16x16x32_bf16(af, b1, Y1, 0, 0, 0);
                if (dw) { const bf16x8 bo = *(const bf16x8*)(ONES + fr * TS72 + kk * 32 + kg * 8); AS = __builtin_amdgcn_mfma_f32_16x16x32_bf16(af, bo, AS, 0, 0, 0); }
            }
            if (dw && fr == 0) {
#pragma unroll
                for (int j = 0; j < 4; ++j) { const int t = tr3 * 16 + kg * 4 + j; const float den = SIN[t] * QN[j] + AS[j]; HD[t] = 1.f / fmaxf(fabsf(den), __expf(-MT[t])); }
            }
        }
        __syncthreads();
        {
#pragma unroll
            for (int j = 0; j < 4; ++j) { const int t = tr3 * 16 + kg * 4 + j; const float si = SIN[t], hd_ = HD[t];
                const int tk = z ? (T - 1 - (s0 + t)) : (s0 + t), row = row0 + tk;
                bf16_t* hp = Hout + (size_t)row * 1024 + hd * 256 + es * 64;
                hp[te0 * 16 + fr] = (bf16_t)pk2((si * X0[j] + Y0[j]) * hd_, 0.f);
                hp[(te0 + 1) * 16 + fr] = (bf16_t)pk2((si * X1[j] + Y1[j]) * hd_, 0.f); }
        }
        {
            const float decay = SCAL[0];
            bf16x8 wf4[2][2];
#pragma unroll
            for (int a = 0; a < 2; ++a) { wf4[a][0] = *(const bf16x8*)(WKT + ((2 * wave + a) * 16 + fr) * TS72 + kg * 8); wf4[a][1] = *(const bf16x8*)(WKT + ((2 * wave + a) * 16 + fr) * TS72 + 32 + kg * 8); }
#pragma unroll
            for (int et = 0; et < 4; ++et) {
                const bf16x8 bv0 = *(const bf16x8*)(VT + (et * 16 + fr) * TS72 + kg * 8), bv1 = *(const bf16x8*)(VT + (et * 16 + fr) * TS72 + 32 + kg * 8);
#pragma unroll
                for (int a = 0; a < 2; ++a) {
                    f32x4 c = cacc[a][et] * decay;
                    c = __builtin_amdgcn_mfma_f32_16x16x32_bf16(wf4[a][0], bv0, c, 0, 0, 0);
                    c = __builtin_amdgcn_mfma_f32_16x16x32_bf16(wf4[a][1], bv1, c, 0, 0, 0);
                    cacc[a][et] = c;
                    const int d = (2 * wave + a) * 16 + kg * 4, e = et * 16 + fr;
                    const f32x4 cz = c + zvm;
                    u32x2 o; o.x = pk2(cz[0], cz[1]); o.y = pk2(cz[2], cz[3]);
                    *(u32x2*)(CT + e * QS + d) = o;
                }
            }
            {
                const bf16x8 on0 = *(const bf16x8*)(ONES + fr * TS72 + kg * 8), on1 = *(const bf16x8*)(ONES + fr * TS72 + 32 + kg * 8);
#pragma unroll
                for (int a = 0; a < 2; ++a) {
                    f32x4 ns = __builtin_amdgcn_mfma_f32_16x16x32_bf16(wf4[a][0], on0, (f32x4){0.f, 0.f, 0.f, 0.f}, 0, 0, 0);
                    ns = __builtin_amdgcn_mfma_f32_16x16x32_bf16(wf4[a][1], on1, ns, 0, 0, 0);
                    if (fr == 0) { const int d0 = (2 * wave + a) * 16 + kg * 4; float* nv = NV + d0;
                        const float n0_ = decay * nv[0] + ns[0], n1_ = decay * nv[1] + ns[1], n2_ = decay * nv[2] + ns[2], n3_ = decay * nv[3] + ns[3];
                        nv[0] = n0_; nv[1] = n1_; nv[2] = n2_; nv[3] = n3_;
                        u32x2 nb2; nb2.x = pk2(n0_, n1_); nb2.y = pk2(n2_, n3_); *(u32x2*)(NVb + d0) = nb2; }
                }
            }
            m = SCAL[1];
        }
        __syncthreads();
    }
    if (Cout) {
#pragma unroll
        for (int a = 0; a < 2; ++a)
#pragma unroll
            for (int et = 0; et < 4; ++et)
#pragma unroll
                for (int j = 0; j < 4; ++j) { const int d = (2 * wave + a) * 16 + kg * 4 + j, e = et * 16 + fr; Cout[(size_t)d * 256 + es * 64 + e] = cacc[a][et][j]; }
        if (es == 0) { if (tid < 256) nout[tid] = NV[tid]; if (tid == 0) mout[0] = m; }
    }
    __syncthreads();
#undef ML_LOAD
}

__device__ __forceinline__ void phase3(const Params& p, unsigned char* lds) {
    const int blk = blockIdx.x;
#ifndef SK3A
    if (p.sub != 2)
    {
    {
        const int b = blk >> 5, hd = (blk >> 1) & 15, z = blk & 1;
        rwkv_chain(p, lds, NPROMPT + b * TS, TS, z, hd, p.in[I_SS] + ((size_t)(b * 2 + z) * 16 + hd) * 4096, nullptr);
    }
    for (int k = 0; k < 2; ++k) {
        const int u = 2 * blk + k, b = u >> 5, hd = (u >> 1) & 15, z = u & 1;
        rwkv_chain(p, lds, b * TP, TP, z, hd, nullptr, p.out + O_S + ((size_t)(b * 2 + z) * 16 + hd) * 4096);
    }
    }
#endif
#ifndef SK3B
    if (p.sub != 1) {
    {
        const int es = blk & 3, z = (blk >> 2) & 1, hd = (blk >> 3) & 3, b = blk >> 5;
        const size_t ci = (size_t)(b * 2 + z) * 4 + hd;
        mlstm_unit(p, lds, NPROMPT + b * TS, TS, z, hd, es, p.in[I_SC] + ci * 65536, p.in[I_SN] + ci * 256, p.in[I_SM] + ci, nullptr, nullptr, nullptr);
    }
    for (int k = 0; k < 2; ++k) {
        const int u = 2 * blk + k, es = u & 3, z = (u >> 2) & 1, hd = (u >> 3) & 3, b = u >> 5;
        const size_t ci = (size_t)(b * 2 + z) * 4 + hd;
        mlstm_unit(p, lds, b * TP, TP, z, hd, es, nullptr, nullptr, nullptr, p.out + O_C + ci * 65536, p.out + O_N + ci * 256, p.out + O_M + ci);
    }
    }
#endif
}

__device__ __forceinline__ void phase4(const Params& p) {
    const int tid = threadIdx.x, lane = tid & 63, wave = __builtin_amdgcn_readfirstlane(tid >> 6);
    bf16_t* P = (bf16_t*)(p.ws + WS_P);
    const bf16_t* HF = (const bf16_t*)((unsigned char*)p.out + Y_HF); const bf16_t* HB = (const bf16_t*)((unsigned char*)p.out + Y_HB);
    const bf16_t* YF = (const bf16_t*)((unsigned char*)p.out + Y_YF); const bf16_t* YB = (const bf16_t*)((unsigned char*)p.out + Y_YB);
    const float* BON = (const float*)(p.ws + WS_BON);
    f32x4 pmg[4], plg[4], plb[4];
#pragma unroll
    for (int j = 0; j < 4; ++j) { pmg[j] = *(const f32x4*)(p.in[I_MLNG] + 16 * lane + 4 * j); plg[j] = *(const f32x4*)(p.in[I_RLNG] + 16 * lane + 4 * j); plb[j] = *(const f32x4*)(p.in[I_RLNB] + 16 * lane + 4 * j); }
    for (int row = blockIdx.x * 8 + wave; row < MROWS; row += gridDim.x * 8) {
        bf16_t* prow = P + (size_t)row * LDP;
        unsigned outm[8];
        {
            const int c0m = 16 * lane;
            float h[16], zz[16];
#pragma unroll
            for (int h8 = 0; h8 < 2; ++h8) {
                const int c = c0m + 8 * h8;
                const u32x4 hf = *(const u32x4*)(HF + (size_t)row * 1024 + c), hb = *(const u32x4*)(HB + (size_t)row * 1024 + c);
                const u32x4 mo = *(const u32x4*)(prow + C_MO + c), mz = *(const u32x4*)(prow + C_MZ + c);
                float* hh = h + 8 * h8; float* zp = zz + 8 * h8;
                hh[0] = sigmoid_f(bflo(mo.x)) * (bflo(hf.x) + bflo(hb.x)); hh[1] = sigmoid_f(bfhi(mo.x)) * (bfhi(hf.x) + bfhi(hb.x));
                hh[2] = sigmoid_f(bflo(mo.y)) * (bflo(hf.y) + bflo(hb.y)); hh[3] = sigmoid_f(bfhi(mo.y)) * (bfhi(hf.y) + bfhi(hb.y));
                hh[4] = sigmoid_f(bflo(mo.z)) * (bflo(hf.z) + bflo(hb.z)); hh[5] = sigmoid_f(bfhi(mo.z)) * (bfhi(hf.z) + bfhi(hb.z));
                hh[6] = sigmoid_f(bflo(mo.w)) * (bflo(hf.w) + bflo(hb.w)); hh[7] = sigmoid_f(bfhi(mo.w)) * (bfhi(hf.w) + bfhi(hb.w));
                zp[0] = silu_f(bflo(mz.x)); zp[1] = silu_f(bfhi(mz.x)); zp[2] = silu_f(bflo(mz.y)); zp[3] = silu_f(bfhi(mz.y));
                zp[4] = silu_f(bflo(mz.z)); zp[5] = silu_f(bfhi(mz.z)); zp[6] = silu_f(bflo(mz.w)); zp[7] = silu_f(bfhi(mz.w));
            }
            float sm = 0.f;
#pragma unroll
            for (int j = 0; j < 16; ++j) sm += h[j];
            const float mu = red16(sm) * (1.f / 256.f);
            float sq = 0.f;
#pragma unroll
            for (int j = 0; j < 16; ++j) { h[j] -= mu; sq += h[j] * h[j]; }
            const float rstd = rsqrtf(red16(sq) * (1.f / 256.f) + EPS);
#pragma unroll
            for (int j = 0; j < 8; ++j) outm[j] = pk2(h[2 * j] * rstd * pmg[j >> 1][(2 * j) & 3] * zz[2 * j], h[2 * j + 1] * rstd * pmg[j >> 1][(2 * j + 1) & 3] * zz[2 * j + 1]);
        }
        const int c0 = 16 * lane, hd = lane >> 2;
        float y[16], vs[16];
        const float bon = BON[(size_t)row * 16 + hd] + BON[(size_t)(MROWS + row) * 16 + hd];
#pragma unroll
        for (int h8 = 0; h8 < 2; ++h8) {
            const int c = c0 + 8 * h8;
            const u32x4 yf = *(const u32x4*)(YF + (size_t)row * 1024 + c), yb = *(const u32x4*)(YB + (size_t)row * 1024 + c);
            const u32x4 vo = *(const u32x4*)(prow + C_MQ + c);
            float* yy = y + 8 * h8; float* vv = vs + 8 * h8;
            yy[0] = bflo(yf.x) + bflo(yb.x); yy[1] = bfhi(yf.x) + bfhi(yb.x); yy[2] = bflo(yf.y) + bflo(yb.y); yy[3] = bfhi(yf.y) + bfhi(yb.y);
            yy[4] = bflo(yf.z) + bflo(yb.z); yy[5] = bfhi(yf.z) + bfhi(yb.z); yy[6] = bflo(yf.w) + bflo(yb.w); yy[7] = bfhi(yf.w) + bfhi(yb.w);
            vv[0] = bflo(vo.x); vv[1] = bfhi(vo.x); vv[2] = bflo(vo.y); vv[3] = bfhi(vo.y); vv[4] = bflo(vo.z); vv[5] = bfhi(vo.z); vv[6] = bflo(vo.w); vv[7] = bfhi(vo.w);
        }
        float s = 0.f;
#pragma unroll
        for (int j = 0; j < 16; ++j) s += y[j];
        const float ym = red4(s) * (1.f / 64.f);
        float s2 = 0.f;
#pragma unroll
        for (int j = 0; j < 16; ++j) { y[j] -= ym; s2 += y[j] * y[j]; }
        const float rstd = rsqrtf(red4(s2) * (1.f / 64.f) + LNX_EPS);
        unsigned outr[8];
#pragma unroll
        for (int h8 = 0; h8 < 2; ++h8) {
            const int c = c0 + 8 * h8;
            const u32x4 rz = *(const u32x4*)(prow + C_RZ + c);
            float o[8];
#pragma unroll
            for (int j = 0; j < 8; ++j) o[j] = y[8 * h8 + j] * rstd * plg[2 * h8 + (j >> 2)][j & 3] + plb[2 * h8 + (j >> 2)][j & 3] + bon * vs[8 * h8 + j];
            o[0] *= silu_f(bflo(rz.x)); o[1] *= silu_f(bfhi(rz.x)); o[2] *= silu_f(bflo(rz.y)); o[3] *= silu_f(bfhi(rz.y));
            o[4] *= silu_f(bflo(rz.z)); o[5] *= silu_f(bfhi(rz.z)); o[6] *= silu_f(bflo(rz.w)); o[7] *= silu_f(bfhi(rz.w));
            outr[4 * h8 + 0] = pk2(o[0], o[1]); outr[4 * h8 + 1] = pk2(o[2], o[3]); outr[4 * h8 + 2] = pk2(o[4], o[5]); outr[4 * h8 + 3] = pk2(o[6], o[7]);
        }
        *(u32x4*)(prow + 16 * lane) = (u32x4){outm[0], outm[1], outm[2], outm[3]};
        *(u32x4*)(prow + 16 * lane + 8) = (u32x4){outm[4], outm[5], outm[6], outm[7]};
        *(u32x4*)(prow + 1024 + c0) = (u32x4){outr[0], outr[1], outr[2], outr[3]};
        *(u32x4*)(prow + 1024 + c0 + 8) = (u32x4){outr[4], outr[5], outr[6], outr[7]};
    }
}

__device__ __forceinline__ void phase6(const Params& p) {
    const int tid = threadIdx.x, lane = tid & 63, wave = __builtin_amdgcn_readfirstlane(tid >> 6);
    const float* fg = p.in[I_FINALG];
    const bf16_t* XN = (const bf16_t*)(p.ws + WS_QKC);
    f32x4 g[4][2];
#pragma unroll
    for (int j = 0; j < 4; ++j) { g[j][0] = *(const f32x4*)(fg + 8 * lane + 512 * j); g[j][1] = *(const f32x4*)(fg + 8 * lane + 512 * j + 4); }
    for (int row = blockIdx.x * 8 + wave; row < MROWS; row += gridDim.x * 8) {
        u32x4 v[4]; float ss = 0.f;
#pragma unroll
        for (int j = 0; j < 4; ++j) v[j] = *(const u32x4*)(XN + (size_t)row * DM + 8 * lane + 512 * j);
        f32x4 a[4][2];
#pragma unroll
        for (int j = 0; j < 4; ++j) { a[j][0] = (f32x4){bflo(v[j].x), bfhi(v[j].x), bflo(v[j].y), bfhi(v[j].y)}; a[j][1] = (f32x4){bflo(v[j].z), bfhi(v[j].z), bflo(v[j].w), bfhi(v[j].w)};
            ss += (a[j][0].x * a[j][0].x + a[j][0].y * a[j][0].y) + (a[j][0].z * a[j][0].z + a[j][0].w * a[j][0].w) + (a[j][1].x * a[j][1].x + a[j][1].y * a[j][1].y) + (a[j][1].z * a[j][1].z + a[j][1].w * a[j][1].w); }
        const float rstd = rsqrtf(wave_sum(ss) * (1.f / DM) + EPS);
        float* o = p.out + (size_t)row * DM + 8 * lane;
#pragma unroll
        for (int j = 0; j < 4; ++j) { *(f32x4*)(o + 512 * j) = a[j][0] * rstd * g[j][0]; *(f32x4*)(o + 512 * j + 4) = a[j][1] * rstd * g[j][1]; }
    }
}

#define XB_TMO      128
#define XB_XCNT(j)  (256  + 64 * (j))
#define XB_XSUB(j)  (1280 + 64 * (j))
#define XB_XGEN(j)  (2304 + 64 * (j))
#define XB_TOP      3328
#define XB_TOPGEN   3392
#define XCD_BAR_WORDS 3456
#define XB_SPIN_CAP (1u << 18)
__device__ __forceinline__ unsigned xb_ld(unsigned* p)              { return __hip_atomic_load(p, __ATOMIC_RELAXED, __HIP_MEMORY_SCOPE_AGENT); }
__device__ __forceinline__ unsigned xb_add(unsigned* p, unsigned v) { return __hip_atomic_fetch_add(p, v, __ATOMIC_RELAXED, __HIP_MEMORY_SCOPE_AGENT); }
__device__ __forceinline__ unsigned xb_xcc_id() { return (unsigned)__builtin_amdgcn_s_getreg((3 << 11) | 20) & 0xFu; }
#define XB_SPIN(cond, bar) do { unsigned _sp = 0; while (cond) { __builtin_amdgcn_s_sleep(1); \
    if ((++_sp & 255u) == 0u) { if (xb_ld(&(bar)[XB_TMO])) break; if (_sp > XB_SPIN_CAP) { atomicAdd(&(bar)[XB_TMO], 1u); break; } } } } while (0)
struct XcdBarrier { unsigned* bar; unsigned x; volatile unsigned* st; };
__device__ __forceinline__ XcdBarrier xcd_barrier_post(unsigned* bar, volatile unsigned* st) {
    XcdBarrier b; b.bar = bar; b.x = xb_xcc_id(); b.st = st;
    if (threadIdx.x == 0) (void)xb_add(&bar[XB_XCNT(b.x)], 1u);
    return b;
}
__device__ __forceinline__ void xcd_barrier_complete(unsigned* bar, unsigned x, unsigned& nloc, unsigned& nx) {
    const unsigned G = gridDim.x * gridDim.y * gridDim.z;
    unsigned sum, cnt, mine, sp = 0u;
    for (;;) {
        sum = 0u; cnt = 0u; mine = 0u;
#pragma unroll
        for (unsigned j = 0; j < 16; ++j) { const unsigned c = xb_ld(&bar[XB_XCNT(j)]); sum += c; cnt += (c > 0u) ? 1u : 0u; mine = (j == x) ? c : mine; }
        if (sum == G) break;
        __builtin_amdgcn_s_sleep(1);
        if ((++sp & 255u) == 0u) { if (xb_ld(&bar[XB_TMO])) break; if (sp > XB_SPIN_CAP) { atomicAdd(&bar[XB_TMO], 1u); break; } }
    }
    nloc = mine > 0u ? mine : 1u; nx = cnt > 0u ? cnt : 1u;
}
__device__ __forceinline__ void xcd_barrier(const XcdBarrier& b) {
    asm volatile("s_waitcnt vmcnt(0)" ::: "memory");
    __syncthreads();
    if (threadIdx.x == 0) {
        unsigned* bar = b.bar;
        __builtin_amdgcn_s_waitcnt(0);
        unsigned nloc = b.st[0], nx = b.st[1];
        if (nloc == 0u) { xcd_barrier_complete(bar, b.x, nloc, nx); b.st[0] = nloc; b.st[1] = nx; }
        const unsigned old = xb_add(&bar[XB_XSUB(b.x)], 1u);
        const unsigned gen = old / nloc;
        if (old + 1u == (gen + 1u) * nloc) {
            __builtin_amdgcn_fence(__ATOMIC_RELEASE, "agent");
            asm volatile("s_waitcnt vmcnt(0)" ::: "memory");
            const unsigned og = xb_add(&bar[XB_TOP], 1u);
            const unsigned tg = og / nx;
            if (og + 1u == (tg + 1u) * nx) xb_add(&bar[XB_TOPGEN], 1u);
            else XB_SPIN(xb_ld(&bar[XB_TOPGEN]) == tg, bar);
            __builtin_amdgcn_fence(__ATOMIC_ACQUIRE, "agent");
            xb_add(&bar[XB_XGEN(b.x)], 1u);
            asm volatile("s_waitcnt vmcnt(0)" ::: "memory");
        } else {
            XB_SPIN(xb_ld(&bar[XB_XGEN(b.x)]) == gen, bar);
            __builtin_amdgcn_fence(__ATOMIC_ACQUIRE, "agent");
            asm volatile("s_waitcnt vmcnt(0)" ::: "memory");
        }
    }
    __syncthreads();
}

__global__ void __launch_bounds__(512, 2) mega_fwd(Params p) {
    extern __shared__ __attribute__((aligned(16))) unsigned char lds[];
    cg::grid_group grid = cg::this_grid();
    const int lo = p.ph_lo, hi = p.ph_hi;
#define IN(k) (lo <= (k) && (k) < hi)
    volatile unsigned* bst = (volatile unsigned*)(lds + LDS_BYTES - 16);
    if (threadIdx.x == 0) { bst[0] = 0u; bst[1] = 0u; }
    __syncthreads();
    XcdBarrier xbar; xbar.bar = (unsigned*)(p.ws + WS_BAR); xbar.x = 0; xbar.st = bst;
    if (hi - lo > 1) xbar = xcd_barrier_post((unsigned*)(p.ws + WS_BAR), bst);
    if (lo == 0x7fff) grid.sync();
#define SEAM(k) do { if (IN(k) && IN((k) + 1)) xcd_barrier(xbar); } while (0)
#ifndef SK0
    if (IN(0)) phase0(p, lds);
#endif
    SEAM(0);
#ifndef SK1
    if (IN(1)) phase1(p, lds);
#endif
    SEAM(1);
#ifndef SK2
    if (IN(2)) {
        pg8::Gemm g{(const bf16_t*)((unsigned char*)p.out + Y_H), (const bf16_t*)(p.ws + WS_WINT), MROWS, NPAD, DM, DM};
        pg8::StaticOrder S; S.init(MROWS, NPAD, gridDim.x, (int)blockIdx.x);
        pg8::EpiP E{(bf16_t*)(p.ws + WS_P), (float*)(p.ws + WS_G32)};
        pg8::gemm_phase<pg8::EpiP>((PG8_LAS unsigned char*)lds, g, S, E);
    }
#endif
    SEAM(2);
    if (IN(3)) phase_prep(p);
    SEAM(3);
#ifndef SK3
    if (IN(4)) phase3(p, lds);
#endif
    SEAM(4);
#ifndef SK4
    if (IN(5)) phase4(p);
#endif
    SEAM(5);
#ifndef SK5
    if (IN(6)) {
        pg8::Gemm g{(const bf16_t*)(p.ws + WS_P), (const bf16_t*)(p.ws + WS_WOUTT), MROWS, DM, DM, LDP};
        pg8::StaticOrder S; S.init(MROWS, DM, gridDim.x, (int)blockIdx.x);
        pg8::EpiRes E{p.in[I_XP], p.in[I_XS], (const float*)(p.ws + WS_MOD), (bf16_t*)(p.ws + WS_QKC)};
        pg8::gemm_phase<pg8::EpiRes>((PG8_LAS unsigned char*)lds, g, S, E);
    }
#endif
    SEAM(6);
#ifndef SK6
    if (IN(7)) phase6(p);
#endif
#undef IN
#undef SEAM
}

extern "C" void kernel_launch(void* const* d_in, const int* in_sizes, int n_in, void* d_out, int out_size, void* d_ws, size_t ws_size, hipStream_t stream) {
    static int state = 0;
    if (state == 0) {
        state = 1;
        if (n_in != 28 || ws_size < WS_END) { fprintf(stderr, "kernel_launch: unexpected n_in %d / ws_size %zu (need %zu)\n", n_in, ws_size, (size_t)WS_END); state = -1; }
        if (hipFuncSetAttribute((const void*)mega_fwd, hipFuncAttributeMaxDynamicSharedMemorySize, LDS_BYTES) != hipSuccess) { fprintf(stderr, "kernel_launch: hipFuncSetAttribute failed\n"); state = -1; }
        int per_cu = 0, dev = 0, cus = 0;
        (void)hipGetDevice(&dev); (void)hipDeviceGetAttribute(&cus, hipDeviceAttributeMultiprocessorCount, dev);
        if (hipOccupancyMaxActiveBlocksPerMultiprocessor(&per_cu, (const void*)mega_fwd, 512, LDS_BYTES) != hipSuccess || per_cu < 1 || cus < 256) { fprintf(stderr, "kernel_launch: occupancy %d x %d CUs cannot hold 256 workgroups\n", per_cu, cus); state = -1; }
        (void)hipGetLastError();
    }
    if (state < 0) return;
    if (hipMemsetAsync((char*)d_ws + WS_BAR, 0, 16384, stream) != hipSuccess) { fprintf(stderr, "kernel_launch: memset failed\n"); return; }
    Params p{};
    for (int i = 0; i < 28; ++i) p.in[i] = (const float*)d_in[i];
    p.out = (float*)d_out; p.ws = (unsigned char*)d_ws;
#if REP >= 0
    for (int k = 0; k < 8; ++k) for (int r = 0; r < (k == REP / 10 ? 2 : 1); ++r) { p.ph_lo = k; p.ph_hi = k + 1; p.sub = r ? REP % 10 : 0; hipLaunchKernelGGL(mega_fwd, dim3(256), dim3(512), LDS_BYTES, stream, p); }
#elif N_LAUNCHES == 1
    p.ph_lo = 0; p.ph_hi = 8;
    void* args[] = {&p};
    hipError_t e = hipLaunchCooperativeKernel((void*)mega_fwd, dim3(256), dim3(512), args, LDS_BYTES, stream);
    if (e != hipSuccess) fprintf(stderr, "cooperative launch failed: %s\n", hipGetErrorString(e));
#else
    for (int k = 0; k < 8; ++k) { p.ph_lo = k; p.ph_hi = k + 1; hipLaunchKernelGGL(mega_fwd, dim3(256), dim3(512), LDS_BYTES, stream, p); }
#endif
}
```

```cpp
#include <hip/hip_runtime.h>
#include <hip/hip_cooperative_groups.h>
#include <cstdio>
namespace cg = cooperative_groups;

#ifndef REP
#define REP -1
#endif
#ifndef N_LAUNCHES
#define N_LAUNCHES 1
#endif

typedef unsigned short bf16_t;
typedef short bf16x8 __attribute__((ext_vector_type(8)));
typedef float f32x4 __attribute__((ext_vector_type(4)));
typedef unsigned u32x4 __attribute__((ext_vector_type(4)));
typedef unsigned u32x2 __attribute__((ext_vector_type(2)));

constexpr int DM = 2048, MROWS = 20480, NPROMPT = 4096, TP = 256, TS = 2048;
constexpr int LDP = 9472;
constexpr int NPAD = 9728;
constexpr int C_MQ = 0, C_MK = 1024, C_MV = 2048, C_MO = 3072, C_MZ = 4096, C_RZ = 5120, C_RR = 6144, C_RK = 7168, C_RV = 8192, C_WD = 9216, C_AD = 9344;
constexpr float EPS = 1e-6f, LNX_EPS = 64e-5f;
constexpr int LDS_BYTES = 163840;

constexpr size_t WS_BAR = 0x7C0000, WS_MODP = 0, WS_MOD = 2u << 20, WS_G32 = 3u << 20, WS_BON = 5u << 20, WS_P = 8u << 20;
constexpr size_t WS_WINT = 398458880ull, WS_QKC = WS_WINT  , WS_WOUTT = WS_QKC + (size_t)MROWS * 2048 * 2, WS_XL = WS_WOUTT + (size_t)2048 * 2048 * 2, WS_END = WS_XL + (size_t)MROWS * 256 * 2;
static_assert(WS_END <= 536870912ull, "ws map");
static_assert(WS_P + (size_t)MROWS * LDP * 2 <= WS_WINT, "ws map");
constexpr size_t O_YP = 0, O_YS = 8388608, O_C = 41943040, O_N = 50331648, O_M = 50364416, O_S = 50364544;
constexpr size_t Y_H = 0, Y_HF = 0, Y_HB = 41943040, Y_YF = 83886080, Y_YB = 125829120;

struct Params {
    const float* in[28];
    float* out; unsigned char* ws; int ph_lo, ph_hi, sub, pad;
};
enum { I_XP = 0, I_XS, I_SC, I_SN, I_SM, I_SS, I_C, I_CCTX, I_NORMG, I_WADA, I_BADA, I_WIN, I_CONVW, I_CONVB, I_GATEB, I_MLNG, I_RMU, I_RW0, I_RW2, I_RA0, I_RA2, I_RKK, I_RKA, I_RRK, I_RLNG, I_RLNB, I_WOUT, I_FINALG };

__device__ __forceinline__ float bf2f(unsigned b) { return __uint_as_float(b << 16); }
__device__ __forceinline__ float bflo(unsigned w) { return __uint_as_float(w << 16); }
__device__ __forceinline__ float bfhi(unsigned w) { return __uint_as_float(w & 0xffff0000u); }
__device__ __forceinline__ unsigned pk2(float lo, float hi) { unsigned r; asm("v_cvt_pk_bf16_f32 %0, %1, %2" : "=v"(r) : "v"(lo), "v"(hi)); return r; }
__device__ __forceinline__ unsigned f2bf(float f) { unsigned u = __float_as_uint(f); return (u + 0x7fffu + ((u >> 16) & 1u)) >> 16; }
__device__ __forceinline__ float opaque_zero() { float z; asm volatile("v_mov_b32 %0, 0" : "=v"(z)); return z; }
__device__ __forceinline__ unsigned pk2_sw(float lo, float hi) { return f2bf(lo) | (f2bf(hi) << 16); }
__device__ __forceinline__ float sigmoid_f(float x) { return __builtin_amdgcn_rcpf(1.f + __expf(-x)); }
__device__ __forceinline__ float silu_f(float x) { return x * __builtin_amdgcn_rcpf(1.f + __expf(-x)); }
__device__ __forceinline__ float softplus_f(float y) { return fmaxf(y, 0.f) + log1pf(__expf(-fabsf(y))); }
__device__ __forceinline__ float wave_sum(float v) {
#pragma unroll
    for (int o = 1; o < 64; o <<= 1) v += __shfl_xor(v, o);
    return v;
}
__device__ __forceinline__ float dpp_f(float v, const int ctrl_sel) {
    int i = __float_as_int(v), r;
    if (ctrl_sel == 0) r = __builtin_amdgcn_update_dpp(0, i, 0xB1, 0xF, 0xF, true);
    else if (ctrl_sel == 1) r = __builtin_amdgcn_update_dpp(0, i, 0x4E, 0xF, 0xF, true);
    else r = __builtin_amdgcn_update_dpp(0, i, 0x141, 0xF, 0xF, true);
    return __int_as_float(r);
}
__device__ __forceinline__ float red8(float v) { v += dpp_f(v, 0); v += dpp_f(v, 1); v += dpp_f(v, 2); return v; }
__device__ __forceinline__ float red4(float v) { v += dpp_f(v, 0); v += dpp_f(v, 1); return v; }

__device__ __forceinline__ float dpp_id(float ident, float v, const int sel) {
    const int o = __float_as_int(ident), i = __float_as_int(v); int r;
    if (sel == 0) r = __builtin_amdgcn_update_dpp(o, i, 0x111, 0xF, 0xF, false);
    else if (sel == 1) r = __builtin_amdgcn_update_dpp(o, i, 0x112, 0xF, 0xF, false);
    else if (sel == 2) r = __builtin_amdgcn_update_dpp(o, i, 0x114, 0xF, 0xF, false);
    else if (sel == 3) r = __builtin_amdgcn_update_dpp(o, i, 0x118, 0xF, 0xF, false);
    else if (sel == 4) r = __builtin_amdgcn_update_dpp(o, i, 0x142, 0xA, 0xF, false);
    else r = __builtin_amdgcn_update_dpp(o, i, 0x143, 0xC, 0xF, false);
    return __int_as_float(r);
}
__device__ __forceinline__ float wave_scan_add(float v) {
    v += dpp_id(0.f, v, 0); v += dpp_id(0.f, v, 1); v += dpp_id(0.f, v, 2); v += dpp_id(0.f, v, 3); v += dpp_id(0.f, v, 4); v += dpp_id(0.f, v, 5); return v;
}
__device__ __forceinline__ float wave_scan_max(float v) {
    const float ni = -INFINITY;
    v = fmaxf(v, dpp_id(ni, v, 0)); v = fmaxf(v, dpp_id(ni, v, 1)); v = fmaxf(v, dpp_id(ni, v, 2)); v = fmaxf(v, dpp_id(ni, v, 3)); v = fmaxf(v, dpp_id(ni, v, 4)); v = fmaxf(v, dpp_id(ni, v, 5)); return v;
}
__device__ __forceinline__ float lane63(float v) { return __int_as_float(__builtin_amdgcn_readlane(__float_as_int(v), 63)); }
__device__ __forceinline__ int row_rid(int row) { return row < NPROMPT ? 0 : 1 + ((row - NPROMPT) >> 11); }
__device__ __forceinline__ void nbrs(int row, int& n0, int& n1, int& n2, int& n3, bool& k0, bool& k1, bool& k2, bool& k3) {
    if (row < NPROMPT) { const int t = row & 255; n0 = n2 = row - 1; k0 = k2 = t > 0; n1 = n3 = row + 1; k1 = k3 = t < 255; }
    else { const int t = (row - NPROMPT) & 2047, cc = t & 63, gr = t >> 6;
        n0 = row - 1; k0 = cc > 0; n1 = row + 1; k1 = cc < 63; n2 = row - 64; k2 = gr > 0; n3 = row + 64; k3 = gr < 31; }
}

namespace pg8 {
#define PG8_LAS __attribute__((address_space(3)))
constexpr int BM = 256, BK = 64, HALF = 128, HTB = HALF * BK * 2, STAGE_BYTES = 8 * HTB, NXCD = 8, WGM = 8;
__host__ __device__ __forceinline__ int lds_byte(int r, int c) { const int st = (r >> 4) * 2 + (c >> 5), rr = r & 15, cc = c & 31, ob = rr * 64 + cc * 2; return st * 1024 + (ob ^ (((ob >> 9) & 1) << 5)); }
__host__ __device__ __forceinline__ void stage_rc(int b, int& R, int& C) { const int st = b / 1024, sb = b % 1024, swz = sb ^ (((sb >> 9) & 1) << 5); R = (st >> 1) * 16 + swz / 64; C = (st & 1) * 32 + (swz % 64) / 2; }
__host__ __device__ __forceinline__ int perm32(int rho) { const int n = rho >> 4, i = rho & 15; return 8 * (i >> 2) + 4 * n + (i & 3); }
struct Unit { int pm, pn; };
struct Gemm { const bf16_t* A; const bf16_t* Bt; int M, N, K, lda; };
struct StaticOrder {
    int nM, nN, nwg, G, c;
    __host__ __device__ void init(int M, int N, int G_, int c_) { nM = M / BM; nN = N / BM; nwg = nM * nN; G = G_; c = c_; }
    __host__ __device__ bool next(int i, Unit& u) const {
        const long L = (long)i * G + c; if (L >= nwg) return false;
        int wgid = (int)L; { const int q = nwg / NXCD, r = nwg % NXCD, xcd = wgid % NXCD, off = wgid / NXCD; wgid = (xcd < r ? xcd * (q + 1) : r * (q + 1) + (xcd - r) * q) + off; }
        const int nig = WGM * nN, gid = wgid / nig, fm = gid * WGM, gsz = (nM - fm) < WGM ? (nM - fm) : WGM;
        u.pm = fm + ((wgid % nig) % gsz); u.pn = (wgid % nig) / gsz; return true;
    }
};
__device__ __forceinline__ unsigned cvt_pk_bf16(float lo, float hi) { unsigned r; asm volatile("v_cvt_pk_bf16_f32 %0, %1, %2" : "=v"(r) : "v"(lo), "v"(hi)); return r; }

template <class Epi>
__device__ __forceinline__ void gemm_phase(PG8_LAS unsigned char* lds, const Gemm g, const StaticOrder& S, const Epi& E) {
    const int tid = threadIdx.x, wid = __builtin_amdgcn_readfirstlane(tid >> 6), lane = tid & 63, wr = wid >> 2, wc = wid & 3, fr = lane & 15, fq = lane >> 4;
    const int K = g.K, nt = K / BK, lda = g.lda;
    unsigned voffA[2], voffB[2];
#pragma unroll
    for (int i = 0; i < 2; ++i) { int R, C; stage_rc(tid * 16 + i * 8192, R, C); const int Rb = Epi::PERM ? ((R & ~31) + perm32(R & 31)) : R;
        voffA[i] = (unsigned)(R * lda + C) * 2u; voffB[i] = (unsigned)(Rb * K + C) * 2u; }
    const size_t kstep = (size_t)(BK * 2);
    const size_t hstepA = (size_t)HALF * lda * 2, hstepB = (size_t)HALF * K * 2;
    const size_t tstepA = 2 * hstepA, tstepB = 2 * hstepB;
    const unsigned ldsw = (unsigned)wid * 1024u;
    const int aoff = lds_byte(wr * 64 + fr, fq * 8), boff = lds_byte(wc * 32 + fr, fq * 8);
#define PG8_SA(b, h) (((b) * 2 + (h)) * HTB)
#define PG8_SB(b, h) ((4 + (b) * 2 + (h)) * HTB)
#define PG8_STAGE(bufoff, gbase, voff) do { _Pragma("unroll") for (int _i = 0; _i < 2; ++_i) \
        __builtin_amdgcn_global_load_lds((const unsigned*)((const char*)(gbase) + (voff)[_i]), (PG8_LAS unsigned*)(lds + (bufoff) + ldsw + _i * 8192), 16, 0, 0); } while (0)
#define PG8_LDA(dst, b, h) do { _Pragma("unroll") for (int m = 0; m < 4; ++m) _Pragma("unroll") for (int k = 0; k < 2; ++k) dst[m][k] = *(const PG8_LAS bf16x8*)(lds + PG8_SA(b, h) + aoff + m * 2048 + k * 1024); } while (0)
#define PG8_LDB(dst, b, h) do { _Pragma("unroll") for (int n = 0; n < 2; ++n) _Pragma("unroll") for (int k = 0; k < 2; ++k) dst[n][k] = *(const PG8_LAS bf16x8*)(lds + PG8_SB(b, h) + boff + n * 2048 + k * 1024); } while (0)
#define PG8_MMA(ai, bj, At, Bt) do { __builtin_amdgcn_s_setprio(1); _Pragma("unroll") for (int m = 0; m < 4; ++m) _Pragma("unroll") for (int n = 0; n < 2; ++n) _Pragma("unroll") for (int k = 0; k < 2; ++k) \
        acc[ai][bj][m][n] = __builtin_amdgcn_mfma_f32_16x16x32_bf16(Bt[n][k], At[m][k], acc[ai][bj][m][n], 0, 0, 0); __builtin_amdgcn_s_setprio(0); } while (0)
#define PG8_WAIT_V(n) asm volatile("s_waitcnt vmcnt(" #n ")" ::: "memory")
#define PG8_WAIT_L(n) asm volatile("s_waitcnt lgkmcnt(" #n ")" ::: "memory")
#define PG8_BAR __builtin_amdgcn_s_barrier()
#define PG8_SCHED __builtin_amdgcn_sched_barrier(0)
    Unit cur, nxt; int ui = 0;
    if (!S.next(0, cur)) return;
    f32x4 acc[2][2][4][2];
#pragma unroll
    for (int a = 0; a < 2; ++a)
#pragma unroll
        for (int b = 0; b < 2; ++b)
#pragma unroll
            for (int m = 0; m < 4; ++m)
#pragma unroll
                for (int n = 0; n < 2; ++n) acc[a][b][m][n] = (f32x4){0.f, 0.f, 0.f, 0.f};
    bf16x8 At[4][2], B0[2][2], B1[2][2];
    const char* cA = (const char*)g.A + (size_t)cur.pm * tstepA; const char* cB = (const char*)g.Bt + (size_t)cur.pn * tstepB;
    PG8_STAGE(PG8_SB(0, 0), cB, voffB); PG8_STAGE(PG8_SA(0, 0), cA, voffA); PG8_STAGE(PG8_SB(0, 1), cB + hstepB, voffB); PG8_STAGE(PG8_SA(0, 1), cA + hstepA, voffA);
    if (wr == 1) PG8_BAR;
    PG8_WAIT_V(4); PG8_BAR;
    PG8_STAGE(PG8_SB(1, 0), cB + kstep, voffB); PG8_STAGE(PG8_SA(1, 0), cA + kstep, voffA); PG8_STAGE(PG8_SB(1, 1), cB + hstepB + kstep, voffB);
    PG8_WAIT_V(6); PG8_BAR;
    for (;;) {
        const bool has_next = S.next(ui + 1, nxt);
        const char* nA = has_next ? (const char*)g.A + (size_t)nxt.pm * tstepA : cA; const char* nB = has_next ? (const char*)g.Bt + (size_t)nxt.pn * tstepB : cB;
        for (int t = 0; t < nt; t += 2) {
            const bool last = (t == nt - 2);
            const char* a1 = cA + (size_t)(t + 1) * kstep;
            const char* a2 = last ? nA : cA + (size_t)(t + 2) * kstep; const char* b2 = last ? nB : cB + (size_t)(t + 2) * kstep;
            const char* a3 = a2 + kstep; const char* b3 = b2 + kstep;
            PG8_LDB(B0, 0, 0); PG8_SCHED; PG8_LDA(At, 0, 0); PG8_STAGE(PG8_SA(1, 1), a1 + hstepA, voffA);
            PG8_WAIT_L(8); PG8_BAR; PG8_WAIT_L(0); PG8_MMA(0, 0, At, B0); PG8_BAR; PG8_SCHED;
            PG8_LDB(B1, 0, 1); PG8_STAGE(PG8_SB(0, 0), b2, voffB);
            PG8_BAR; PG8_WAIT_L(0); PG8_MMA(0, 1, At, B1); PG8_BAR;
            PG8_LDA(At, 0, 1); PG8_STAGE(PG8_SA(0, 0), a2, voffA);
            PG8_BAR; PG8_WAIT_L(0); PG8_MMA(1, 0, At, B0); PG8_BAR; PG8_SCHED;
            PG8_STAGE(PG8_SB(0, 1), b2 + hstepB, voffB);
            PG8_WAIT_V(6); PG8_BAR; PG8_MMA(1, 1, At, B1); PG8_BAR;
            PG8_LDB(B0, 1, 0); PG8_SCHED; PG8_LDA(At, 1, 0); PG8_STAGE(PG8_SA(0, 1), a2 + hstepA, voffA);
            PG8_WAIT_L(8); PG8_BAR; PG8_WAIT_L(0); PG8_MMA(0, 0, At, B0); PG8_BAR; PG8_SCHED;
            PG8_LDB(B1, 1, 1); PG8_STAGE(PG8_SB(1, 0), b3, voffB);
            PG8_BAR; PG8_WAIT_L(0); PG8_MMA(0, 1, At, B1); PG8_BAR;
            PG8_LDA(At, 1, 1); PG8_STAGE(PG8_SA(1, 0), a3, voffA);
            PG8_BAR; PG8_WAIT_L(0); PG8_MMA(1, 0, At, B0); PG8_BAR; PG8_SCHED;
            PG8_STAGE(PG8_SB(1, 1), b3 + hstepB, voffB);
            PG8_WAIT_V(6); PG8_BAR; PG8_MMA(1, 1, At, B1); PG8_BAR;
        }
        E(acc, cur, wr, wc, fr, fq);
        if (!has_next) break;
#pragma unroll
        for (int a = 0; a < 2; ++a)
#pragma unroll
            for (int b = 0; b < 2; ++b)
#pragma unroll
                for (int m = 0; m < 4; ++m)
#pragma unroll
                    for (int n = 0; n < 2; ++n) acc[a][b][m][n] = (f32x4){0.f, 0.f, 0.f, 0.f};
        cur = nxt; cA = nA; cB = nB; ++ui;
    }
    PG8_WAIT_V(0);
    if (wr == 0) PG8_BAR;
    PG8_BAR;
#undef PG8_SA
#undef PG8_SB
#undef PG8_STAGE
#undef PG8_LDA
#undef PG8_LDB
#undef PG8_MMA
#undef PG8_WAIT_V
#undef PG8_WAIT_L
#undef PG8_BAR
#undef PG8_SCHED
}

struct EpiP {
    static constexpr bool PERM = true;
    bf16_t* P; float* G32;
    __device__ __forceinline__ void operator()(const f32x4 (&acc)[2][2][4][2], const Unit& u, int wr, int wc, int fr, int fq) const {
        const int row0 = u.pm * BM + wr * 64 + fr;
        if (u.pn < 37) {
            const int col0 = u.pn * BM + wc * 32 + 8 * fq;
#pragma unroll
            for (int ai = 0; ai < 2; ++ai)
#pragma unroll
                for (int m = 0; m < 4; ++m) { bf16_t* rowp = P + (size_t)(row0 + ai * HALF + m * 16) * LDP + col0;
#pragma unroll
                    for (int bj = 0; bj < 2; ++bj) { const f32x4 v0 = acc[ai][bj][m][0], v1 = acc[ai][bj][m][1];
                        u32x4 w; w.x = cvt_pk_bf16(v0[0], v0[1]); w.y = cvt_pk_bf16(v0[2], v0[3]); w.z = cvt_pk_bf16(v1[0], v1[1]); w.w = cvt_pk_bf16(v1[2], v1[3]);
                        *(u32x4*)(rowp + bj * HALF) = w; } }
        } else if (wc == 0 && fq < 2) {
#pragma unroll
            for (int ai = 0; ai < 2; ++ai)
#pragma unroll
                for (int m = 0; m < 4; ++m) { float* rowp = G32 + (size_t)(row0 + ai * HALF + m * 16) * 16 + 8 * fq;
                    *(f32x4*)(rowp) = acc[ai][0][m][0]; *(f32x4*)(rowp + 4) = acc[ai][0][m][1]; }
        }
    }
};
struct EpiRes {
    static constexpr bool PERM = true;
    const float* xp; const float* xs; const float* MOD; bf16_t* XN;
    __device__ __forceinline__ void operator()(const f32x4 (&acc)[2][2][4][2], const Unit& u, int wr, int wc, int fr, int fq) const {
        const int col0 = u.pn * BM + wc * 32 + 8 * fq;
        const int rid = row_rid(u.pm * BM);
        const float* x = (u.pm < 16) ? xp + (size_t)(u.pm * BM) * DM : xs + (size_t)(u.pm * BM - NPROMPT) * DM;
        f32x4 gv[2][2];
#pragma unroll
        for (int bj = 0; bj < 2; ++bj)
#pragma unroll
            for (int n = 0; n < 2; ++n) gv[bj][n] = *(const f32x4*)(MOD + (size_t)rid * 6144 + 4096 + col0 + bj * HALF + 4 * n);
        const float* xb = x + (size_t)(wr * 64 + fr) * DM + col0;
        bf16_t* ob = XN + (size_t)(u.pm * BM + wr * 64 + fr) * DM + col0;
#pragma unroll
        for (int ai = 0; ai < 2; ++ai)
#pragma unroll
            for (int mp = 0; mp < 2; ++mp) {
                f32x4 xv[2][2][2];
#pragma unroll
                for (int mm = 0; mm < 2; ++mm)
#pragma unroll
                    for (int bj = 0; bj < 2; ++bj)
#pragma unroll
                        for (int n = 0; n < 2; ++n) xv[mm][bj][n] = *(const f32x4*)(xb + (size_t)(ai * HALF + (mp * 2 + mm) * 16) * DM + bj * HALF + 4 * n);
                asm volatile("" ::: "memory");
#pragma unroll
                for (int mm = 0; mm < 2; ++mm)
#pragma unroll
                    for (int bj = 0; bj < 2; ++bj) {
                        const f32x4 v0 = xv[mm][bj][0] + gv[bj][0] * acc[ai][bj][mp * 2 + mm][0], v1 = xv[mm][bj][1] + gv[bj][1] * acc[ai][bj][mp * 2 + mm][1];
                        u32x4 w; w.x = pk2(v0[0], v0[1]); w.y = pk2(v0[2], v0[3]); w.z = pk2(v1[0], v1[1]); w.w = pk2(v1[2], v1[3]);
                        *(u32x4*)(ob + (size_t)(ai * HALF + (mp * 2 + mm) * 16) * DM + bj * HALF) = w;
                    }
                asm volatile("" ::: "memory");
            }
    }
};
}

__device__ __forceinline__ void transpose_item(const float* W, int ldw, int srccol, bf16_t* WT, int K, int dst_n0, int k0, float* scr, int lane) {
    float tv[32];
#pragma unroll
    for (int i = 0; i < 32; ++i) { const int kk = 2 * i + (lane >> 5); tv[i] = srccol >= 0 ? W[(size_t)(k0 + kk) * ldw + srccol] : 0.f; }
#pragma unroll
    for (int i = 0; i < 32; ++i) { const int kk = 2 * i + (lane >> 5); scr[kk * 33 + (lane & 31)] = tv[i]; }
    asm volatile("s_waitcnt lgkmcnt(0)" ::: "memory");
    const int c = lane & 7;
#pragma unroll
    for (int j = 0; j < 4; ++j) { const int n = (lane >> 3) + 8 * j; const float* s = scr + (8 * c) * 33 + n;
        u32x4 o; o.x = pk2(s[0 * 33], s[1 * 33]); o.y = pk2(s[2 * 33], s[3 * 33]); o.z = pk2(s[4 * 33], s[5 * 33]); o.w = pk2(s[6 * 33], s[7 * 33]);
        *(u32x4*)(WT + (size_t)(dst_n0 + n) * K + k0 + 8 * c) = o; }
    asm volatile("s_waitcnt lgkmcnt(0)" ::: "memory");
}
__device__ __forceinline__ void phase0(const Params& p, unsigned char* lds) {
    const int tid = threadIdx.x, lane = tid & 63, wave = __builtin_amdgcn_readfirstlane(tid >> 6);
    float* sc = (float*)lds;
    float* scr = (float*)(lds + 73728) + wave * (64 * 33);
    for (int i = tid; i < 9 * 2048; i += 512) { const int r = i >> 11, k = i & 2047; const float v = r == 0 ? p.in[I_CCTX][k] : p.in[I_C][(r - 1) * 2048 + k]; sc[i] = silu_f(v); }
    __syncthreads();
    const int gw = blockIdx.x * 8 + wave, NGW = gridDim.x * 8;
    constexpr int I_GV = 192 * 8, I_IN = 32 * 297, I_OUT = 32 * 64;
    bf16_t* WinT = (bf16_t*)(p.ws + WS_WINT); bf16_t* WoutT = (bf16_t*)(p.ws + WS_WOUTT); float* MODP = (float*)(p.ws + WS_MODP);
    for (int it = gw; it < I_GV + I_IN + I_OUT; it += NGW) {
        if (it < I_GV) {
            const int ng = it % 192, kb = it / 192, col = ng * 32 + (lane & 31), kh = lane >> 5;
            float acc[9];
#pragma unroll
            for (int r = 0; r < 9; ++r) acc[r] = 0.f;
            const float* wp = p.in[I_WADA] + (size_t)(kb * 256 + kh) * 6144 + col;
#pragma unroll 16
            for (int i = 0; i < 128; ++i) { const float w = wp[(size_t)(2 * i) * 6144]; const int k = kb * 256 + 2 * i + kh;
#pragma unroll
                for (int r = 0; r < 9; ++r) acc[r] += sc[r * 2048 + k] * w; }
#pragma unroll
            for (int r = 0; r < 9; ++r) { acc[r] += __shfl_xor(acc[r], 32); if (lane < 32) MODP[(size_t)(kb * 9 + r) * 6144 + col] = acc[r]; }
        } else if (it < I_GV + I_IN) {
            const int j = it - I_GV, kb = j / 297, ng = j % 297, n = ng * 32 + (lane & 31);
            const int src = n < 5120 ? n : (n < 9472 ? n + 16 : (n < 9488 ? n - 9472 + 5120 : -1));
            transpose_item(p.in[I_WIN], 9488, src, WinT, 2048, ng * 32, kb * 64, scr, lane);
        } else {
            const int j = it - I_GV - I_IN, kb = j / 64, ng = j % 64;
            transpose_item(p.in[I_WOUT], 2048, ng * 32 + (lane & 31), WoutT, 2048, ng * 32, kb * 64, scr, lane);
        }
    }
}

__device__ __forceinline__ void phase1(const Params& p, unsigned char* lds) {
    const int tid = threadIdx.x, lane = tid & 63, wave = __builtin_amdgcn_readfirstlane(tid >> 6);
    const float* MODP = (const float*)(p.ws + WS_MODP); float* MOD = (float*)(p.ws + WS_MOD);
    const float* b_ada = p.in[I_BADA];
    for (int i = blockIdx.x * 512 + tid; i < 9 * 6144; i += gridDim.x * 512) { const int n = i % 6144; float s = b_ada[n];
#pragma unroll
        for (int kb = 0; kb < 8; ++kb) s += MODP[(size_t)kb * 9 * 6144 + i];
        MOD[i] = s; }
    float* A = (float*)lds; float* B = A + 4096;
    const int rpb = MROWS / gridDim.x, rowbase = blockIdx.x * rpb;
    const int r_lo = row_rid(rowbase), r_hi = row_rid(rowbase + rpb - 1);
    for (int idx = tid; idx < 4096; idx += 512) { const int which = idx >> 11, n = idx & 2047, r = which ? r_hi : r_lo;
        float sh = b_ada[n], scl = b_ada[2048 + n];
#pragma unroll
        for (int kb = 0; kb < 8; ++kb) { sh += MODP[(size_t)(kb * 9 + r) * 6144 + n]; scl += MODP[(size_t)(kb * 9 + r) * 6144 + 2048 + n]; }
        A[idx] = p.in[I_NORMG][n] * (1.f + scl); B[idx] = sh; }
    __syncthreads();
    bf16_t* H = (bf16_t*)((unsigned char*)p.out + Y_H);
    for (int row = rowbase + wave; row < rowbase + rpb; row += 8) {
        const float* x = row < NPROMPT ? p.in[I_XP] + (size_t)row * DM : p.in[I_XS] + (size_t)(row - NPROMPT) * DM;
        const int sel = (row_rid(row) == r_lo) ? 0 : 2048;
        f32x4 v[8]; float ss = 0.f;
#pragma unroll
        for (int j = 0; j < 8; ++j) { v[j] = *(const f32x4*)(x + 4 * lane + 256 * j); ss += (v[j].x * v[j].x + v[j].y * v[j].y) + (v[j].z * v[j].z + v[j].w * v[j].w); }
        const float rstd = rsqrtf(wave_sum(ss) * (1.f / DM) + EPS);
#pragma unroll
        for (int j = 0; j < 8; ++j) { const int c = 4 * lane + 256 * j; const f32x4 a = *(const f32x4*)(A + sel + c), b = *(const f32x4*)(B + sel + c);
            u32x2 o; o.x = pk2(v[j].x * rstd * a.x + b.x, v[j].y * rstd * a.y + b.y); o.y = pk2(v[j].z * rstd * a.z + b.z, v[j].w * rstd * a.w + b.w);
            *(u32x2*)(H + (size_t)row * DM + c) = o; }
    }
}

__device__ __forceinline__ float shift_mix(float x, float sh, float mu) { return x + mu * (sh - x); }
__device__ __forceinline__ float fast_tanh(float x) { return 1.f - 2.f * __builtin_amdgcn_rcpf(1.f + __expf(2.f * x)); }
__device__ __forceinline__ void phase_prep(const Params& p) {
    const int tid = threadIdx.x, lane = tid & 63, wave = __builtin_amdgcn_readfirstlane(tid >> 6);
    const bf16_t* P = (const bf16_t*)(p.ws + WS_P);
    bf16_t* QKC = (bf16_t*)(p.ws + WS_QKC); bf16_t* XL = (bf16_t*)(p.ws + WS_XL);
    const float* cw = p.in[I_CONVW]; const float* cb = p.in[I_CONVB];
    {
        const int o8 = (tid & 255) * 8, half = tid >> 8, rpb = MROWS / gridDim.x, rbeg = blockIdx.x * rpb + half * (rpb / 2), rend = rbeg + rpb / 2;
        const f32x4 w0a = *(const f32x4*)(cw + o8), w0b = *(const f32x4*)(cw + o8 + 4), w1a = *(const f32x4*)(cw + 2048 + o8), w1b = *(const f32x4*)(cw + 2052 + o8), w2a = *(const f32x4*)(cw + 4096 + o8), w2b = *(const f32x4*)(cw + 4100 + o8);
        const f32x4 ba = *(const f32x4*)(cb + o8), bb = *(const f32x4*)(cb + o8 + 4);
        const float sc = o8 >= 1024 ? 0.0625f : 1.f;
        const u32x4 zero = (u32x4){0u, 0u, 0u, 0u};
        u32x4 xm = rbeg > 0 ? *(const u32x4*)(P + (size_t)(rbeg - 1) * LDP + o8) : zero;
        u32x4 xc = *(const u32x4*)(P + (size_t)rbeg * LDP + o8);
#pragma unroll 1
        for (int rb = rbeg; rb < rend; rb += 8) {
            u32x4 xb[8];
#pragma unroll
            for (int i = 0; i < 8; ++i) xb[i] = (rb + i + 1 < MROWS) ? *(const u32x4*)(P + (size_t)(rb + i + 1) * LDP + o8) : zero;
#pragma unroll
            for (int i = 0; i < 8; ++i) {
                const int row = rb + i; const u32x4 xn = xb[i];
                const int T = row < NPROMPT ? TP : TS, tk = row < NPROMPT ? (row & 255) : ((row - NPROMPT) & 2047);
                const u32x4 x0 = tk > 0 ? xm : zero, x1 = xc, x2 = tk < T - 1 ? xn : zero;
                float o[8];
                o[0] = ba.x + w0a.x * bflo(x0.x) + w1a.x * bflo(x1.x) + w2a.x * bflo(x2.x);
                o[1] = ba.y + w0a.y * bfhi(x0.x) + w1a.y * bfhi(x1.x) + w2a.y * bfhi(x2.x);
                o[2] = ba.z + w0a.z * bflo(x0.y) + w1a.z * bflo(x1.y) + w2a.z * bflo(x2.y);
                o[3] = ba.w + w0a.w * bfhi(x0.y) + w1a.w * bfhi(x1.y) + w2a.w * bfhi(x2.y);
                o[4] = bb.x + w0b.x * bflo(x0.z) + w1b.x * bflo(x1.z) + w2b.x * bflo(x2.z);
                o[5] = bb.y + w0b.y * bfhi(x0.z) + w1b.y * bfhi(x1.z) + w2b.y * bfhi(x2.z);
                o[6] = bb.z + w0b.z * bflo(x0.w) + w1b.z * bflo(x1.w) + w2b.z * bflo(x2.w);
                o[7] = bb.w + w0b.w * bfhi(x0.w) + w1b.w * bfhi(x1.w) + w2b.w * bfhi(x2.w);
#pragma unroll
                for (int e = 0; e < 8; ++e) o[e] = silu_f(o[e]) * sc;
                u32x4 ov; ov.x = pk2(o[0], o[1]); ov.y = pk2(o[2], o[3]); ov.z = pk2(o[4], o[5]); ov.w = pk2(o[6], o[7]);
                *(u32x4*)(QKC + (size_t)row * 2048 + o8) = ov;
                xm = xc; xc = xn;
            }
        }
    }
    for (int row = blockIdx.x * 8 + wave; row < MROWS; row += gridDim.x * 8) {
        const bf16_t* prow = P + (size_t)row * LDP;
        {
            int n0, n1, n2, n3; bool k0, k1, k2, k3; nbrs(row, n0, n1, n2, n3, k0, k1, k2, k3);
            const int cl = 4 * lane; const u32x2 z2 = (u32x2){0u, 0u};
            const u32x2 own = *(const u32x2*)(prow + C_WD + cl);
            const u32x2 v0 = k0 ? *(const u32x2*)(P + (size_t)n0 * LDP + C_WD + cl) : z2, v1 = k1 ? *(const u32x2*)(P + (size_t)n1 * LDP + C_WD + cl) : z2;
            const u32x2 v2 = k2 ? *(const u32x2*)(P + (size_t)n2 * LDP + C_WD + cl) : z2, v3 = k3 ? *(const u32x2*)(P + (size_t)n3 * LDP + C_WD + cl) : z2;
            const f32x4 mu = *(const f32x4*)(p.in[I_RMU] + 3072 + cl);
            float a = bflo(own.x), b = bfhi(own.x), c = bflo(own.y), d = bfhi(own.y);
            a += mu.x * (bflo(v0.x) - a); b += mu.y * (bfhi(v1.x) - b); c += mu.z * (bflo(v2.y) - c); d += mu.w * (bfhi(v3.y) - d);
            if (lane < 32) { a = fast_tanh(a); b = fast_tanh(b); c = fast_tanh(c); d = fast_tanh(d); }
            u32x2 o; o.x = pk2(a, b); o.y = pk2(c, d);
            *(u32x2*)(XL + (size_t)row * 256 + cl) = o;
        }
    }
}

constexpr int RCH = 32;
typedef float f32x2 __attribute__((ext_vector_type(2)));
__device__ __forceinline__ float dpp_rowmirror(float v) { return __int_as_float(__builtin_amdgcn_update_dpp(0, __float_as_int(v), 0x140, 0xF, 0xF, true)); }
__device__ __forceinline__ float red16(float v) { v += dpp_f(v, 0); v += dpp_f(v, 1); v += dpp_f(v, 2); v += dpp_rowmirror(v); return v; }
struct RwkvRaw { u32x4 xl[2][2]; u32x2 own[3], nb[4][3]; };
template <int KS> __device__ __forceinline__ f32x4 tile_mm(const bf16_t* A, int pa, const bf16_t* B, int pb, int fr, int kg, f32x4 acc) {
#pragma unroll
    for (int kk = 0; kk < KS; ++kk) {
        const bf16x8 a = *(const bf16x8*)(A + fr * pa + kk * 32 + kg * 8), b = *(const bf16x8*)(B + fr * pb + kk * 32 + kg * 8);
        acc = __builtin_amdgcn_mfma_f32_16x16x32_bf16(a, b, acc, 0, 0, 0);
    }
    return acc;
}
__device__ __forceinline__ void store_nat(bf16_t* Z, int pz, int n0, int m0, int fr, int kg, f32x4 v, float zv) {
    v = v + zv;
    u32x2 o; o.x = pk2(v[0], v[1]); o.y = pk2(v[2], v[3]); *(u32x2*)(Z + (n0 + fr) * pz + m0 + kg * 4) = o;
}
constexpr int VP = 72, TP40 = 40;
__device__ void rwkv_chain(const Params& p, unsigned char* lds, int row0, int T, int z, int hd, const float* S0, float* Sout) {
    const int tid = threadIdx.x, lane = tid & 63, wave = __builtin_amdgcn_readfirstlane(tid >> 6);
    const bf16_t* P = (const bf16_t*)(p.ws + WS_P);
    const bf16_t* XL = (const bf16_t*)(p.ws + WS_XL);
    float* LW = (float*)lds;
    float* AA = LW + 2048;
    float* DL = AA + 2048;
    float* DEND = DL + 2048;
    bf16_t* ALb = (bf16_t*)(DEND + 64);
    bf16_t* RHb = ALb + 32 * VP;
    bf16_t* BEb = RHb + 32 * VP;
    bf16_t* KAb = BEb + 32 * VP;
    bf16_t* BET = KAb + 32 * VP;
    bf16_t* KAT = BET + 64 * TP40;
    bf16_t* VVT = KAT + 64 * TP40;
    bf16_t* Sb = VVT + 64 * TP40;
    bf16_t* NDg = Sb + 64 * VP;
    bf16_t* NDt = NDg + 4 * 16 * TP40;
    bf16_t* HD = NDt + 4 * 16 * TP40;
    bf16_t* N12T = HD + 4 * 16 * TP40;
    bf16_t* HH = N12T + 16 * TP40;
    bf16_t* TKT = HH + 32 * TP40;
    bf16_t* PBT = TKT + 32 * TP40;
    bf16_t* PKT = PBT + 32 * TP40;
    bf16_t* Wb = PKT + 32 * TP40;
    bf16_t* Ub = Wb + 64 * TP40;
    const float zv = opaque_zero();
    bf16_t* Yout = (bf16_t*)((unsigned char*)p.out + (z ? Y_YB : Y_YF));
    float* BON = (float*)(p.ws + WS_BON) + (size_t)z * MROWS * 16;
    const int type = wave >> 2, tile = wave & 3, fr = lane & 15, kg = lane >> 4;
    bf16x8 Bfrag[2];
    {
        const float* W2 = (type ? p.in[I_RA2] : p.in[I_RW2]) + (size_t)z * 64 * 1024 + hd * 64 + tile * 16 + fr;
#pragma unroll
        for (int kk = 0; kk < 2; ++kk) {
            float w[8];
#pragma unroll
            for (int j = 0; j < 8; ++j) w[j] = W2[(size_t)(kk * 32 + kg * 8 + j) * 1024];
            u32x4 t; t.x = pk2(w[0], w[1]); t.y = pk2(w[2], w[3]); t.z = pk2(w[4], w[5]); t.w = pk2(w[6], w[7]);
            Bfrag[kk] = __builtin_bit_cast(bf16x8, t);
        }
    }
    const int ccA = tile * 16 + fr;
    const float biasA = type ? p.in[I_RA0][z * 1024 + hd * 64 + ccA] : p.in[I_RW0][z * 1024 + hd * 64 + ccA];
    const int pB = tid >> 4, c4 = 4 * (tid & 15), cB = hd * 64 + c4;
    const f32x4 mur = *(const f32x4*)(p.in[I_RMU] + cB), muk = *(const f32x4*)(p.in[I_RMU] + 1024 + cB), muv = *(const f32x4*)(p.in[I_RMU] + 2048 + cB);
    const f32x4 kkc = *(const f32x4*)(p.in[I_RKK] + cB), kac = *(const f32x4*)(p.in[I_RKA] + cB), rkc = *(const f32x4*)(p.in[I_RRK] + cB);
    const int jt = wave >> 1, it0 = (wave & 1) * 2;
    f32x4 sacc[2];
#pragma unroll
    for (int a = 0; a < 2; ++a) {
        const int i = (it0 + a) * 16 + fr, j = jt * 16 + kg * 4;
        sacc[a] = S0 ? *(const f32x4*)(S0 + (size_t)i * 64 + j) : (f32x4){0.f, 0.f, 0.f, 0.f};
        u32x2 o; o.x = pk2(sacc[a][0], sacc[a][1]); o.y = pk2(sacc[a][2], sacc[a][3]); *(u32x2*)(Sb + i * VP + j) = o;
    }

    for (int i = tid; i < (int)((Ub + 64 * TP40) - NDg) / 2; i += 512) ((unsigned*)NDg)[i] = 0u;
    RwkvRaw raw;
#define RW_LOAD(s0_) do { \
        _Pragma("unroll") for (int tt = 0; tt < 2; ++tt) { const int tkA = z ? (T - 1 - ((s0_) + tt * 16 + fr)) : ((s0_) + tt * 16 + fr); \
            const bf16_t* xr = XL + (size_t)(row0 + tkA) * 256 + type * 128 + z * 64 + kg * 8; \
            raw.xl[tt][0] = *(const u32x4*)(xr); raw.xl[tt][1] = *(const u32x4*)(xr + 32); } \
        const int tkL = z ? (T - 1 - ((s0_) + pB)) : ((s0_) + pB), rowL = row0 + tkL; \
        int n_[4]; bool k_[4]; nbrs(rowL, n_[0], n_[1], n_[2], n_[3], k_[0], k_[1], k_[2], k_[3]); \
        const bf16_t* pr = P + (size_t)rowL * LDP + cB; \
        raw.own[0] = *(const u32x2*)(pr + C_RR); raw.own[1] = *(const u32x2*)(pr + C_RK); raw.own[2] = *(const u32x2*)(pr + C_RV); \
        _Pragma("unroll") for (int g = 0; g < 4; ++g) { const bf16_t* pn = P + (size_t)n_[g] * LDP + cB; const u32x2 z2 = (u32x2){0u, 0u}; \
            raw.nb[g][0] = k_[g] ? *(const u32x2*)(pn + C_RR) : z2; raw.nb[g][1] = k_[g] ? *(const u32x2*)(pn + C_RK) : z2; raw.nb[g][2] = k_[g] ? *(const u32x2*)(pn + C_RV) : z2; } \
    } while (0)

    RW_LOAD(0);
    {
        {
            float lwv[2][4];
#pragma unroll
            for (int tt = 0; tt < 2; ++tt) {
                f32x4 acc = (f32x4){0.f, 0.f, 0.f, 0.f};
                acc = __builtin_amdgcn_mfma_f32_16x16x32_bf16(__builtin_bit_cast(bf16x8, raw.xl[tt][0]), Bfrag[0], acc, 0, 0, 0);
                acc = __builtin_amdgcn_mfma_f32_16x16x32_bf16(__builtin_bit_cast(bf16x8, raw.xl[tt][1]), Bfrag[1], acc, 0, 0, 0);
#pragma unroll
                for (int j = 0; j < 4; ++j) { const int pp = tt * 16 + kg * 4 + j; const float x = biasA + acc[j];
                    if (type == 0) { const float lw = -0.60653066f * __builtin_amdgcn_rcpf(1.f + __expf(-x)); lwv[tt][j] = lw; LW[pp * 64 + ccA] = lw; }
                    else { lwv[tt][j] = 0.f; AA[pp * 64 + ccA] = __builtin_amdgcn_rcpf(1.f + __expf(-x)); } }
            }
            if (type == 0) { float carry = 0.f;
#pragma unroll
                for (int tt = 0; tt < 2; ++tt) {
                    const float p0 = lwv[tt][0], p1 = p0 + lwv[tt][1], p2 = p1 + lwv[tt][2], p3 = p2 + lwv[tt][3];
                    float inc = p3; const float t1 = __shfl_up(inc, 16); if (lane >= 16) inc += t1; const float t2 = __shfl_up(inc, 32); if (lane >= 32) inc += t2;
                    const float ex = inc - p3 + carry; const int pp = tt * 16 + kg * 4;
                    DL[(pp + 0) * 64 + ccA] = ex + p0; DL[(pp + 1) * 64 + ccA] = ex + p1; DL[(pp + 2) * 64 + ccA] = ex + p2; DL[(pp + 3) * 64 + ccA] = ex + p3;
                    carry += __shfl(inc, 48 + fr); } }
        }
    }
    __syncthreads();
    for (int s0 = 0; s0 < T; s0 += RCH) {
        {
            const int tkB = z ? (T - 1 - (s0 + pB)) : (s0 + pB), rowB = row0 + tkB;
            f32x4 rs, ks, vs;
            rs.x = shift_mix(bflo(raw.own[0].x), bflo(raw.nb[0][0].x), mur.x); rs.y = shift_mix(bfhi(raw.own[0].x), bfhi(raw.nb[1][0].x), mur.y);
            rs.z = shift_mix(bflo(raw.own[0].y), bflo(raw.nb[2][0].y), mur.z); rs.w = shift_mix(bfhi(raw.own[0].y), bfhi(raw.nb[3][0].y), mur.w);
            ks.x = shift_mix(bflo(raw.own[1].x), bflo(raw.nb[0][1].x), muk.x); ks.y = shift_mix(bfhi(raw.own[1].x), bfhi(raw.nb[1][1].x), muk.y);
            ks.z = shift_mix(bflo(raw.own[1].y), bflo(raw.nb[2][1].y), muk.z); ks.w = shift_mix(bfhi(raw.own[1].y), bfhi(raw.nb[3][1].y), muk.w);
            vs.x = shift_mix(bflo(raw.own[2].x), bflo(raw.nb[0][2].x), muv.x); vs.y = shift_mix(bfhi(raw.own[2].x), bfhi(raw.nb[1][2].x), muv.y);
            vs.z = shift_mix(bflo(raw.own[2].y), bflo(raw.nb[2][2].y), muv.z); vs.w = shift_mix(bfhi(raw.own[2].y), bfhi(raw.nb[3][2].y), muv.w);
            f32x4 kk = ks * kkc;
            const float nn = red16((kk.x * kk.x + kk.y * kk.y) + (kk.z * kk.z + kk.w * kk.w));
            kk = kk * fminf(__builtin_amdgcn_rsqf(nn), 1e12f);
            const f32x4 a = *(const f32x4*)(AA + pB * 64 + c4), lw = *(const f32x4*)(LW + pB * 64 + c4), dl = *(const f32x4*)(DL + pB * 64 + c4);
            const f32x4 bv = kk * a; const f32x4 kz = ks * (1.f + (a - 1.f) * kac);
            const f32x4 t1_ = rs * kz;
            const float bon = red16((t1_.x * rkc.x + t1_.y * rkc.y) + (t1_.z * rkc.z + t1_.w * rkc.w));
            f32x4 eD, eP, iD;
            eD.x = __expf(dl.x); eD.y = __expf(dl.y); eD.z = __expf(dl.z); eD.w = __expf(dl.w);
            eP.x = __expf(dl.x - lw.x); eP.y = __expf(dl.y - lw.y); eP.z = __expf(dl.z - lw.z); eP.w = __expf(dl.w - lw.w);
            iD.x = __expf(-dl.x); iD.y = __expf(-dl.y); iD.z = __expf(-dl.z); iD.w = __expf(-dl.w);
            const f32x4 al = -(kk * eP), rh = rs * eD, be = bv * iD, ka = kz * iD;
            u32x2 o;
            o.x = pk2(al.x, al.y); o.y = pk2(al.z, al.w); *(u32x2*)(ALb + pB * VP + c4) = o;
            o.x = pk2(rh.x, rh.y); o.y = pk2(rh.z, rh.w); *(u32x2*)(RHb + pB * VP + c4) = o;
            o.x = pk2(be.x, be.y); o.y = pk2(be.z, be.w); *(u32x2*)(BEb + pB * VP + c4) = o;
            o.x = pk2(ka.x, ka.y); o.y = pk2(ka.z, ka.w); *(u32x2*)(KAb + pB * VP + c4) = o;
            { const unsigned b0 = pk2(be.x, be.y), b1 = pk2(be.z, be.w), k0_ = pk2(ka.x, ka.y), k1_ = pk2(ka.z, ka.w), v0_ = pk2(vs.x, vs.y), v1_ = pk2(vs.z, vs.w);
              BET[(c4 + 0) * TP40 + pB] = (bf16_t)b0; BET[(c4 + 1) * TP40 + pB] = (bf16_t)(b0 >> 16); BET[(c4 + 2) * TP40 + pB] = (bf16_t)b1; BET[(c4 + 3) * TP40 + pB] = (bf16_t)(b1 >> 16);
              KAT[(c4 + 0) * TP40 + pB] = (bf16_t)k0_; KAT[(c4 + 1) * TP40 + pB] = (bf16_t)(k0_ >> 16); KAT[(c4 + 2) * TP40 + pB] = (bf16_t)k1_; KAT[(c4 + 3) * TP40 + pB] = (bf16_t)(k1_ >> 16);
              VVT[(c4 + 0) * TP40 + pB] = (bf16_t)v0_; VVT[(c4 + 1) * TP40 + pB] = (bf16_t)(v0_ >> 16); VVT[(c4 + 2) * TP40 + pB] = (bf16_t)v1_; VVT[(c4 + 3) * TP40 + pB] = (bf16_t)(v1_ >> 16); }
            if ((tid & 15) == 0) BON[(size_t)rowB * 16 + hd] = bon;
            if (z == 0) { u32x2 ov; ov.x = pk2(vs.x, vs.y); ov.y = pk2(vs.z, vs.w); *(u32x2*)(const_cast<bf16_t*>(P) + (size_t)rowB * LDP + C_MQ + cB) = ov; }
            if (pB == RCH - 1) *(f32x4*)(DEND + c4) = eD;
        }
        if (s0 + RCH < T) RW_LOAD(s0 + RCH);
        __syncthreads();
#pragma unroll
        for (int qi = 0; qi < 2; ++qi) {
            const int q = wave + 8 * qi; if (q >= 14) break;
            int grp, mt, nt;
            if (q < 3) { grp = 0; mt = (q == 1) ? 1 : 0; nt = (q == 0) ? 0 : 1; }
            else if (q < 5) { grp = 1; mt = nt = q - 3; }
            else { const int r = (q - 5) % 3; grp = 2 + (q - 5) / 3; mt = (r == 2) ? 1 : 0; nt = (r == 0) ? 0 : 1; }
            const bf16_t* Aop = (grp == 0 || grp == 3) ? BEb : (grp == 1 ? ALb : KAb);
            const bf16_t* Bop = (grp == 1) ? BEb : (grp >= 3 ? RHb : ALb);
            f32x4 d = tile_mm<2>(Aop + mt * 16 * VP, VP, Bop + nt * 16 * VP, VP, fr, kg, (f32x4){0.f, 0.f, 0.f, 0.f});
            const int n = nt * 16 + fr, m0 = mt * 16 + kg * 4;
            f32x4 h = d;
#pragma unroll
            for (int j = 0; j < 4; ++j) { const int m = m0 + j;
                const bool keep = (grp == 1) ? (n < m) : ((grp >= 3) ? (m <= n) : (m < n));
                d[j] = keep ? d[j] : 0.f; h[j] = d[j] + ((m == n) ? 1.f : 0.f); }
            if (grp == 0) {
                if (mt == nt) { store_nat(NDt + mt * 16 * TP40, TP40, 0, 0, fr, kg, d, zv); store_nat(HD + mt * 16 * TP40, TP40, 0, 0, fr, kg, h, zv); }
                else store_nat(N12T, TP40, 0, 0, fr, kg, d, zv);
            } else if (grp == 1) store_nat(NDg + mt * 16 * TP40, TP40, 0, 0, fr, kg, d, zv);
            else store_nat(grp == 2 ? TKT : (grp == 3 ? PBT : PKT), TP40, nt * 16, mt * 16, fr, kg, d, zv);
        }
        __syncthreads();
        const int tt = wave >> 2, itw = wave & 3;
        {
            f32x4 d = tile_mm<2>(ALb + tt * 16 * VP, VP, Sb + itw * 16 * VP, VP, fr, kg, (f32x4){0.f, 0.f, 0.f, 0.f});
            d = tile_mm<1>(TKT + tt * 16 * TP40, TP40, VVT + itw * 16 * TP40, TP40, fr, kg, d);
            store_nat(Wb, TP40, itw * 16, tt * 16, fr, kg, d, zv);
        }
        if (wave < 2) {
            const int blk = wave;
#define ND_G(buf) (NDg + ((buf) * 2 + blk) * 16 * TP40)
#define ND_T(buf) (NDt + ((buf) * 2 + blk) * 16 * TP40)
#define HD_(buf) (HD + ((buf) * 2 + blk) * 16 * TP40)
#define LWAIT() asm volatile("s_waitcnt lgkmcnt(0)" ::: "memory")
            const f32x4 zf = (f32x4){0.f, 0.f, 0.f, 0.f};
#pragma unroll
            for (int st = 1; st <= 4; ++st) {
                const int cur = (st - 1) & 1, nxt = st & 1;
                LWAIT();
                if (st >= 2) {
                    const bf16_t* Ho = HD_(st & 1);
                    f32x4 d = tile_mm<1>(ND_G(cur), TP40, Ho, TP40, fr, kg, zf);
                    const u32x2 ho = *(const u32x2*)(Ho + fr * TP40 + kg * 4);
                    d[0] += bflo(ho.x); d[1] += bfhi(ho.x); d[2] += bflo(ho.y); d[3] += bfhi(ho.y);
                    if (st < 4) store_nat(HD_((st + 1) & 1), TP40, 0, 0, fr, kg, d, zv);
                    else store_nat(HH, TP40, blk * 16, blk * 16, fr, kg, d, zv);
                }
                if (st <= 3) {
                    const f32x4 dg = tile_mm<1>(ND_T(cur), TP40, ND_G(cur), TP40, fr, kg, zf);
                    const f32x4 dt = tile_mm<1>(ND_G(cur), TP40, ND_T(cur), TP40, fr, kg, zf);
                    store_nat(ND_G(nxt), TP40, 0, 0, fr, kg, dg, zv); store_nat(ND_T(nxt), TP40, 0, 0, fr, kg, dt, zv);
                }
            }
#undef ND_G
#undef ND_T
#undef HD_
        }
        __syncthreads();
        if (wave < 4) {
            const int it = wave;
            const f32x4 zf = (f32x4){0.f, 0.f, 0.f, 0.f};
            f32x4 d = tile_mm<1>(HH, TP40, Wb + it * 16 * TP40, TP40, fr, kg, zf);
            store_nat(Ub, TP40, it * 16, 0, fr, kg, d, zv);
            LWAIT();
            d = tile_mm<1>(N12T, TP40, Ub + it * 16 * TP40, TP40, fr, kg, zf);
            { const u32x2 wo = *(const u32x2*)(Wb + (it * 16 + fr) * TP40 + 16 + kg * 4);
              d[0] += bflo(wo.x); d[1] += bfhi(wo.x); d[2] += bflo(wo.y); d[3] += bfhi(wo.y); }
            store_nat(Wb, TP40, it * 16, 16, fr, kg, d, zv);
            LWAIT();
            d = tile_mm<1>(HH + 16 * TP40, TP40, Wb + it * 16 * TP40, TP40, fr, kg, zf);
            store_nat(Ub, TP40, it * 16, 16, fr, kg, d, zv);
        }
#undef LWAIT
        __syncthreads();
        {
            f32x4 d = tile_mm<2>(RHb + tt * 16 * VP, VP, Sb + itw * 16 * VP, VP, fr, kg, (f32x4){0.f, 0.f, 0.f, 0.f});
            d = tile_mm<1>(PBT + tt * 16 * TP40, TP40, Ub + itw * 16 * TP40, TP40, fr, kg, d);
            d = tile_mm<1>(PKT + tt * 16 * TP40, TP40, VVT + itw * 16 * TP40, TP40, fr, kg, d);
#pragma unroll
            for (int j = 0; j < 4; ++j) { const int t = tt * 16 + kg * 4 + j, tk = z ? (T - 1 - (s0 + t)) : (s0 + t);
                Yout[(size_t)(row0 + tk) * 1024 + hd * 64 + itw * 16 + fr] = (bf16_t)pk2(d[j] + zv, 0.f); }
        }
        const f32x4 dend = *(const f32x4*)(DEND + jt * 16 + kg * 4);
#pragma unroll
        for (int a = 0; a < 2; ++a) {
            f32x4 c = tile_mm<1>(BET + jt * 16 * TP40, TP40, Ub + (it0 + a) * 16 * TP40, TP40, fr, kg, sacc[a]);
            c = tile_mm<1>(KAT + jt * 16 * TP40, TP40, VVT + (it0 + a) * 16 * TP40, TP40, fr, kg, c);
            sacc[a] = c * dend;
        }
        if (s0 + RCH < T) {
        {
            float lwv[2][4];
#pragma unroll
            for (int tt = 0; tt < 2; ++tt) {
                f32x4 acc = (f32x4){0.f, 0.f, 0.f, 0.f};
                acc = __builtin_amdgcn_mfma_f32_16x16x32_bf16(__builtin_bit_cast(bf16x8, raw.xl[tt][0]), Bfrag[0], acc, 0, 0, 0);
                acc = __builtin_amdgcn_mfma_f32_16x16x32_bf16(__builtin_bit_cast(bf16x8, raw.xl[tt][1]), Bfrag[1], acc, 0, 0, 0);
#pragma unroll
                for (int j = 0; j < 4; ++j) { const int pp = tt * 16 + kg * 4 + j; const float x = biasA + acc[j];
                    if (type == 0) { const float lw = -0.60653066f * __builtin_amdgcn_rcpf(1.f + __expf(-x)); lwv[tt][j] = lw; LW[pp * 64 + ccA] = lw; }
                    else { lwv[tt][j] = 0.f; AA[pp * 64 + ccA] = __builtin_amdgcn_rcpf(1.f + __expf(-x)); } }
            }
            if (type == 0) { float carry = 0.f;
#pragma unroll
                for (int tt = 0; tt < 2; ++tt) {
                    const float p0 = lwv[tt][0], p1 = p0 + lwv[tt][1], p2 = p1 + lwv[tt][2], p3 = p2 + lwv[tt][3];
                    float inc = p3; const float t1 = __shfl_up(inc, 16); if (lane >= 16) inc += t1; const float t2 = __shfl_up(inc, 32); if (lane >= 32) inc += t2;
                    const float ex = inc - p3 + carry; const int pp = tt * 16 + kg * 4;
                    DL[(pp + 0) * 64 + ccA] = ex + p0; DL[(pp + 1) * 64 + ccA] = ex + p1; DL[(pp + 2) * 64 + ccA] = ex + p2; DL[(pp + 3) * 64 + ccA] = ex + p3;
                    carry += __shfl(inc, 48 + fr); } }
        }
        }
        __syncthreads();
#pragma unroll
        for (int a = 0; a < 2; ++a) { const int i = (it0 + a) * 16 + fr, j = jt * 16 + kg * 4;
            u32x2 o; o.x = pk2(sacc[a][0], sacc[a][1]); o.y = pk2(sacc[a][2], sacc[a][3]); *(u32x2*)(Sb + i * VP + j) = o; }
    }
#undef RW_LOAD
    if (Sout) {
#pragma unroll
        for (int a = 0; a < 2; ++a) { const int i = (it0 + a) * 16 + fr, j = jt * 16 + kg * 4; *(f32x4*)(Sout + (size_t)i * 64 + j) = sacc[a]; }
    }
    __syncthreads();
}

constexpr int QS = 264, TS72 = 72;
__device__ void mlstm_unit(const Params& p, unsigned char* lds, int row0, int T, int z, int hd, int es,
                           const float* C0, const float* n0, const float* m0p, float* Cout, float* nout, float* mout) {
    const int tid = threadIdx.x, lane = tid & 63, wave = __builtin_amdgcn_readfirstlane(tid >> 6), fr = lane & 15, kg = lane >> 4;
    const bf16_t* P = (const bf16_t*)(p.ws + WS_P);
    const float* G32 = (const float*)(p.ws + WS_G32);
    bf16_t* Q = (bf16_t*)lds;
    bf16_t* Kc = Q + 64 * QS;
    bf16_t* CT = Kc + 64 * QS;
    bf16_t* NVb = CT + 64 * QS;
    bf16_t* WKT = NVb + QS;
    bf16_t* VT = WKT + 256 * TS72;
    bf16_t* AM = VT + 64 * TS72;
    float* NV = (float*)(AM + 64 * TS72);
    float* BB = NV + 256; float* IB = BB + 64; float* MT = IB + 64; float* SIN = MT + 64; float* WF = SIN + 64; float* HD = WF + 64; float* SCAL = HD + 64;
    bf16_t* ONES = (bf16_t*)(SCAL + 4);
    bf16_t* Hout = (bf16_t*)((unsigned char*)p.out + (z ? Y_HB : Y_HF));
    const bf16_t* QKC = (const bf16_t*)(p.ws + WS_QKC);
    const float zvm = opaque_zero();
    const int d8 = tid & 31, pg = tid >> 5;
    const float gbi = p.in[I_GATEB][z * 8 + hd], gbf = p.in[I_GATEB][z * 8 + 4 + hd];
    const int vp = tid >> 3, ve8 = (tid & 7) * 8;
    u32x4 pq[4], pk[4], pv; float pgi = 0.f, pgf = 0.f;
#define ML_LOAD(s0_) do { \
        _Pragma("unroll") for (int i = 0; i < 4; ++i) { const int pp_ = pg + 16 * i, tk_ = z ? (T - 1 - ((s0_) + pp_)) : ((s0_) + pp_); \
            const bf16_t* qr = QKC + (size_t)(row0 + tk_) * 2048 + hd * 256 + d8 * 8; pq[i] = *(const u32x4*)qr; pk[i] = *(const u32x4*)(qr + 1024); } \
        { const int tk_ = z ? (T - 1 - ((s0_) + vp)) : ((s0_) + vp); pv = *(const u32x4*)(P + (size_t)(row0 + tk_) * LDP + C_MV + hd * 256 + es * 64 + ve8); } \
        if (wave == 0) { const int tk_ = z ? (T - 1 - ((s0_) + lane)) : ((s0_) + lane); const float* gr = G32 + (size_t)(row0 + tk_) * 16 + z * 8 + hd; pgi = gr[0]; pgf = gr[4]; } \
    } while (0)
    f32x4 cacc[2][4];
#pragma unroll
    for (int a = 0; a < 2; ++a)
#pragma unroll
        for (int et = 0; et < 4; ++et) {
#pragma unroll
            for (int j = 0; j < 4; ++j) { const int d = (2 * wave + a) * 16 + kg * 4 + j, e = et * 16 + fr;
                cacc[a][et][j] = C0 ? C0[(size_t)d * 256 + es * 64 + e] : 0.f; }
            const int d = (2 * wave + a) * 16 + kg * 4, e = et * 16 + fr;
            u32x2 o; o.x = pk2(cacc[a][et][0], cacc[a][et][1]); o.y = pk2(cacc[a][et][2], cacc[a][et][3]);
            *(u32x2*)(CT + e * QS + d) = o;
        }
    if (tid < 256) { const float nv0 = n0 ? n0[tid] : 0.f; NV[tid] = nv0; NVb[tid] = (bf16_t)pk2(nv0, 0.f); }
    if (tid < 8) NVb[256 + tid] = (bf16_t)0u;
    for (int i = tid; i < 16 * TS72; i += 512) ONES[i] = (bf16_t)((i < 64) ? 0x3F80u : 0u);
    float m = m0p ? m0p[0] : -INFINITY;
    ML_LOAD(0);
    __syncthreads();

    for (int s0 = 0; s0 < T; s0 += 64) {
        if (wave == 0) {
            const float ig = pgi + gbi;
            const float fpre = pgf + gbf;
            const float fg = -(fmaxf(-fpre, 0.f) + (__builtin_amdgcn_logf(1.f + __expf(-fabsf(fpre))) * 0.69314718f));
            const float b = wave_scan_add(fg);
            const float ib = ig - b; const float cm = wave_scan_max(ib);
            const float bL = lane63(b);
            const float mt = b + fmaxf(m, cm);
            const float g = bL + ib; const float gmax = lane63(cm) + bL;
            const float m_new = fmaxf(bL + m, gmax);
            BB[lane] = b; IB[lane] = ib; MT[lane] = mt; SIN[lane] = __expf(b + m - mt); WF[lane] = __expf(g - m_new);
            if (lane == 0) { SCAL[0] = __expf(bL + m - m_new); SCAL[1] = m_new; }
        }
#pragma unroll
        for (int i = 0; i < 4; ++i) { const int pp = pg + 16 * i; *(u32x4*)(Q + pp * QS + d8 * 8) = pq[i]; *(u32x4*)(Kc + pp * QS + d8 * 8) = pk[i]; }
        VT[(ve8 + 0) * TS72 + vp] = (bf16_t)(pv.x & 0xffffu); VT[(ve8 + 1) * TS72 + vp] = (bf16_t)(pv.x >> 16);
        VT[(ve8 + 2) * TS72 + vp] = (bf16_t)(pv.y & 0xffffu); VT[(ve8 + 3) * TS72 + vp] = (bf16_t)(pv.y >> 16);
        VT[(ve8 + 4) * TS72 + vp] = (bf16_t)(pv.z & 0xffffu); VT[(ve8 + 5) * TS72 + vp] = (bf16_t)(pv.z >> 16);
        VT[(ve8 + 6) * TS72 + vp] = (bf16_t)(pv.w & 0xffffu); VT[(ve8 + 7) * TS72 + vp] = (bf16_t)(pv.w >> 16);
        __syncthreads();
        if (s0 + 64 < T) ML_LOAD(s0 + 64);
        {
            const int d = tid & 255, ph = tid >> 8;
#pragma unroll
            for (int i = 0; i < 4; ++i) { const int po = ph * 4 + i; float w[8];
#pragma unroll
                for (int j = 0; j < 8; ++j) w[j] = WF[po * 8 + j] * bf2f((unsigned)Kc[(po * 8 + j) * QS + d]);
                u32x4 o; o.x = pk2(w[0], w[1]); o.y = pk2(w[2], w[3]); o.z = pk2(w[4], w[5]); o.w = pk2(w[6], w[7]);
                *(u32x4*)(WKT + d * TS72 + po * 8) = o; }
        }
        {
            const int tr = wave >> 1, tc0 = (wave & 1) * 2;
            f32x4 a0 = (f32x4){0.f, 0.f, 0.f, 0.f}, a1 = a0;
#pragma unroll
            for (int kk = 0; kk < 8; ++kk) {
                const bf16x8 af = *(const bf16x8*)(Q + (tr * 16 + fr) * QS + kk * 32 + kg * 8);
                const bf16x8 b0 = *(const bf16x8*)(Kc + (tc0 * 16 + fr) * QS + kk * 32 + kg * 8);
                const bf16x8 b1 = *(const bf16x8*)(Kc + ((tc0 + 1) * 16 + fr) * QS + kk * 32 + kg * 8);
                a0 = __builtin_amdgcn_mfma_f32_16x16x32_bf16(af, b0, a0, 0, 0, 0);
                a1 = __builtin_amdgcn_mfma_f32_16x16x32_bf16(af, b1, a1, 0, 0, 0);
            }
#pragma unroll
            for (int j = 0; j < 4; ++j) { const int t = tr * 16 + kg * 4 + j; const float bt = BB[t] - MT[t];
                { const int s = tc0 * 16 + fr; const float w = __expf(fminf(bt + IB[s], 0.f)) * ((s <= t) ? a0[j] : 0.f); AM[t * TS72 + s] = (bf16_t)pk2(w, w); }
                { const int s = (tc0 + 1) * 16 + fr; const float w = __expf(fminf(bt + IB[s], 0.f)) * ((s <= t) ? a1[j] : 0.f); AM[t * TS72 + s] = (bf16_t)pk2(w, w); } }
        }
        __syncthreads();
        f32x4 X0, X1, Y0, Y1;
        const int tr3 = wave >> 1, te0 = (wave & 1) * 2;
        {
            X0 = (f32x4){0.f, 0.f, 0.f, 0.f}; X1 = X0; Y0 = X0; Y1 = X0;
            f32x4 QN = X0, AS = X0;
            const bool dw = (te0 == 0);
#pragma unroll
            for (int kk = 0; kk < 8; ++kk) {
                const bf16x8 af = *(const bf16x8*)(Q + (tr3 * 16 + fr) * QS + kk * 32 + kg * 8);
                const bf16x8 b0 = *(const bf16x8*)(CT + (te0 * 16 + fr) * QS + kk * 32 + kg * 8);
                const bf16x8 b1 = *(const bf16x8*)(CT + ((te0 + 1) * 16 + fr) * QS + kk * 32 + kg * 8);
                X0 = __builtin_amdgcn_mfma_f32_16x16x32_bf16(af, b0, X0, 0, 0, 0);
                X1 = __builtin_amdgcn_mfma_f32_16x16x32_bf16(af, b1, X1, 0, 0, 0);
                if (dw) { const bf16x8 bn = *(const bf16x8*)(CT + (64 + fr) * QS + kk * 32 + kg * 8); QN = __builtin_amdgcn_mfma_f32_16x16x32_bf16(af, bn, QN, 0, 0, 0); }
            }
#pragma unroll
            for (int kk = 0; kk < 2; ++kk) {
                const bf16x8 af = *(const bf16x8*)(AM + (tr3 * 16 + fr) * TS72 + kk * 32 + kg * 8);
                const bf16x8 b0 = *(const bf16x8*)(VT + (te0 * 16 + fr) * TS72 + kk * 32 + kg * 8);
                const bf16x8 b1 = *(const bf16x8*)(VT + ((te0 + 1) * 16 + fr) * TS72 + kk * 32 + kg * 8);
                Y0 = __builtin_amdgcn_mfma_f32_16x16x32_bf16(af, b0, Y0, 0, 0, 0);
                Y1 = __builtin_amdgcn_mfma_f32_16x16x32_bf16(af, b1, Y1, 0, 0, 0);
                if (dw) { const bf16x8 bo = *(const bf16x8*)(ONES + fr * TS72 + kk * 32 + kg * 8); AS = __builtin_amdgcn_mfma_f32_16x16x32_bf16(af, bo, AS, 0, 0, 0); }
            }
            if (dw && fr == 0) {
#pragma unroll
                for (int j = 0; j < 4; ++j) { const int t = tr3 * 16 + kg * 4 + j; const float den = SIN[t] * QN[j] + AS[j]; HD[t] = 1.f / fmaxf(fabsf(den), __expf(-MT[t])); }
            }
        }
        __syncthreads();
        {
#pragma unroll
            for (int j = 0; j < 4; ++j) { const int t = tr3 * 16 + kg * 4 + j; const float si = SIN[t], hd_ = HD[t];
                const int tk = z ? (T - 1 - (s0 + t)) : (s0 + t), row = row0 + tk;
                bf16_t* hp = Hout + (size_t)row * 1024 + hd * 256 + es * 64;
                hp[te0 * 16 + fr] = (bf16_t)pk2((si * X0[j] + Y0[j]) * hd_, 0.f);
                hp[(te0 + 1) * 16 + fr] = (bf16_t)pk2((si * X1[j] + Y1[j]) * hd_, 0.f); }
        }
        {
            const float decay = SCAL[0];
            bf16x8 wf4[2][2];
#pragma unroll
            for (int a = 0; a < 2; ++a) { wf4[a][0] = *(const bf16x8*)(WKT + ((2 * wave + a) * 16 + fr) * TS72 + kg * 8); wf4[a][1] = *(const bf16x8*)(WKT + ((2 * wave + a) * 16 + fr) * TS72 + 32 + kg * 8); }
#pragma unroll
            for (int et = 0; et < 4; ++et) {
                const bf16x8 bv0 = *(const bf16x8*)(VT + (et * 16 + fr) * TS72 + kg * 8), bv1 = *(const bf16x8*)(VT + (et * 16 + fr) * TS72 + 32 + kg * 8);
#pragma unroll
                for (int a = 0; a < 2; ++a) {
                    f32x4 c = cacc[a][et] * decay;
                    c = __builtin_amdgcn_mfma_f32_16x16x32_bf16(wf4[a][0], bv0, c, 0, 0, 0);
                    c = __builtin_amdgcn_mfma_f32_16x16x32_bf16(wf4[a][1], bv1, c, 0, 0, 0);
                    cacc[a][et] = c;
                    const int d = (2 * wave + a) * 16 + kg * 4, e = et * 16 + fr;
                    const f32x4 cz = c + zvm;
                    u32x2 o; o.x = pk2(cz[0], cz[1]); o.y = pk2(cz[2], cz[3]);
                    *(u32x2*)(CT + e * QS + d) = o;
                }
            }
            {
                const bf16x8 on0 = *(const bf16x8*)(ONES + fr * TS72 + kg * 8), on1 = *(const bf16x8*)(ONES + fr * TS72 + 32 + kg * 8);
#pragma unroll
                for (int a = 0; a < 2; ++a) {
                    f32x4 ns = __builtin_amdgcn_mfma_f32_16x16x32_bf16(wf4[a][0], on0, (f32x4){0.f, 0.f, 0.f, 0.f}, 0, 0, 0);
                    ns = __builtin_amdgcn_mfma_f32_16x16x32_bf16(wf4[a][1], on1, ns, 0, 0, 0);
                    if (fr == 0) { const int d0 = (2 * wave + a) * 16 + kg * 4; float* nv = NV + d0;
                        const float n0_ = decay * nv[0] + ns[0], n1_ = decay * nv[1] + ns[1], n2_ = decay * nv[2] + ns[2], n3_ = decay * nv[3] + ns[3];
                        nv[0] = n0_; nv[1] = n1_; nv[2] = n2_; nv[3] = n3_;
                        u32x2 nb2; nb2.x = pk2(n0_, n1_); nb2.y = pk2(n2_, n3_); *(u32x2*)(NVb + d0) = nb2; }
                }
            }
            m = SCAL[1];
        }
        __syncthreads();
    }
    if (Cout) {
#pragma unroll
        for (int a = 0; a < 2; ++a)
#pragma unroll
            for (int et = 0; et < 4; ++et)
#pragma unroll
                for (int j = 0; j < 4; ++j) { const int d = (2 * wave + a) * 16 + kg * 4 + j, e = et * 16 + fr; Cout[(size_t)d * 256 + es * 64 + e] = cacc[a][et][j]; }
        if (es == 0) { if (tid < 256) nout[tid] = NV[tid]; if (tid == 0) mout[0] = m; }
    }
    __syncthreads();
#undef ML_LOAD
}

__device__ __forceinline__ void phase3(const Params& p, unsigned char* lds) {
    const int blk = blockIdx.x;
#ifndef SK3A
    if (p.sub != 2)
    {
    {
        const int b = blk >> 5, hd = (blk >> 1) & 15, z = blk & 1;
        rwkv_chain(p, lds, NPROMPT + b * TS, TS, z, hd, p.in[I_SS] + ((size_t)(b * 2 + z) * 16 + hd) * 4096, nullptr);
    }
    for (int k = 0; k < 2; ++k) {
        const int u = 2 * blk + k, b = u >> 5, hd = (u >> 1) & 15, z = u & 1;
        rwkv_chain(p, lds, b * TP, TP, z, hd, nullptr, p.out + O_S + ((size_t)(b * 2 + z) * 16 + hd) * 4096);
    }
    }
#endif
#ifndef SK3B
    if (p.sub != 1) {
    {
        const int es = blk & 3, z = (blk >> 2) & 1, hd = (blk >> 3) & 3, b = blk >> 5;
        const size_t ci = (size_t)(b * 2 + z) * 4 + hd;
        mlstm_unit(p, lds, NPROMPT + b * TS, TS, z, hd, es, p.in[I_SC] + ci * 65536, p.in[I_SN] + ci * 256, p.in[I_SM] + ci, nullptr, nullptr, nullptr);
    }
    for (int k = 0; k < 2; ++k) {
        const int u = 2 * blk + k, es = u & 3, z = (u >> 2) & 1, hd = (u >> 3) & 3, b = u >> 5;
        const size_t ci = (size_t)(b * 2 + z) * 4 + hd;
        mlstm_unit(p, lds, b * TP, TP, z, hd, es, nullptr, nullptr, nullptr, p.out + O_C + ci * 65536, p.out + O_N + ci * 256, p.out + O_M + ci);
    }
    }
#endif
}

__device__ __forceinline__ void phase4(const Params& p) {
    const int tid = threadIdx.x, lane = tid & 63, wave = __builtin_amdgcn_readfirstlane(tid >> 6);
    bf16_t* P = (bf16_t*)(p.ws + WS_P);
    const bf16_t* HF = (const bf16_t*)((unsigned char*)p.out + Y_HF); const bf16_t* HB = (const bf16_t*)((unsigned char*)p.out + Y_HB);
    const bf16_t* YF = (const bf16_t*)((unsigned char*)p.out + Y_YF); const bf16_t* YB = (const bf16_t*)((unsigned char*)p.out + Y_YB);
    const float* BON = (const float*)(p.ws + WS_BON);
    f32x4 pmg[4], plg[4], plb[4];
#pragma unroll
    for (int j = 0; j < 4; ++j) { pmg[j] = *(const f32x4*)(p.in[I_MLNG] + 16 * lane + 4 * j); plg[j] = *(const f32x4*)(p.in[I_RLNG] + 16 * lane + 4 * j); plb[j] = *(const f32x4*)(p.in[I_RLNB] + 16 * lane + 4 * j); }
    for (int row = blockIdx.x * 8 + wave; row < MROWS; row += gridDim.x * 8) {
        bf16_t* prow = P + (size_t)row * LDP;
        unsigned outm[8];
        {
            const int c0m = 16 * lane;
            float h[16], zz[16];
#pragma unroll
            for (int h8 = 0; h8 < 2; ++h8) {
                const int c = c0m + 8 * h8;
                const u32x4 hf = *(const u32x4*)(HF + (size_t)row * 1024 + c), hb = *(const u32x4*)(HB + (size_t)row * 1024 + c);
                const u32x4 mo = *(const u32x4*)(prow + C_MO + c), mz = *(const u32x4*)(prow + C_MZ + c);
                float* hh = h + 8 * h8; float* zp = zz + 8 * h8;
                hh[0] = sigmoid_f(bflo(mo.x)) * (bflo(hf.x) + bflo(hb.x)); hh[1] = sigmoid_f(bfhi(mo.x)) * (bfhi(hf.x) + bfhi(hb.x));
                hh[2] = sigmoid_f(bflo(mo.y)) * (bflo(hf.y) + bflo(hb.y)); hh[3] = sigmoid_f(bfhi(mo.y)) * (bfhi(hf.y) + bfhi(hb.y));
                hh[4] = sigmoid_f(bflo(mo.z)) * (bflo(hf.z) + bflo(hb.z)); hh[5] = sigmoid_f(bfhi(mo.z)) * (bfhi(hf.z) + bfhi(hb.z));
                hh[6] = sigmoid_f(bflo(mo.w)) * (bflo(hf.w) + bflo(hb.w)); hh[7] = sigmoid_f(bfhi(mo.w)) * (bfhi(hf.w) + bfhi(hb.w));
                zp[0] = silu_f(bflo(mz.x)); zp[1] = silu_f(bfhi(mz.x)); zp[2] = silu_f(bflo(mz.y)); zp[3] = silu_f(bfhi(mz.y));
                zp[4] = silu_f(bflo(mz.z)); zp[5] = silu_f(bfhi(mz.z)); zp[6] = silu_f(bflo(mz.w)); zp[7] = silu_f(bfhi(mz.w));
            }
            float sm = 0.f;
#pragma unroll
            for (int j = 0; j < 16; ++j) sm += h[j];
            const float mu = red16(sm) * (1.f / 256.f);
            float sq = 0.f;
#pragma unroll
            for (int j = 0; j < 16; ++j) { h[j] -= mu; sq += h[j] * h[j]; }
            const float rstd = rsqrtf(red16(sq) * (1.f / 256.f) + EPS);
#pragma unroll
            for (int j = 0; j < 8; ++j) outm[j] = pk2(h[2 * j] * rstd * pmg[j >> 1][(2 * j) & 3] * zz[2 * j], h[2 * j + 1] * rstd * pmg[j >> 1][(2 * j + 1) & 3] * zz[2 * j + 1]);
        }
        const int c0 = 16 * lane, hd = lane >> 2;
        float y[16], vs[16];
        const float bon = BON[(size_t)row * 16 + hd] + BON[(size_t)(MROWS + row) * 16 + hd];
#pragma unroll
        for (int h8 = 0; h8 < 2; ++h8) {
            const int c = c0 + 8 * h8;
            const u32x4 yf = *(const u32x4*)(YF + (size_t)row * 1024 + c), yb = *(const u32x4*)(YB + (size_t)row * 1024 + c);
            const u32x4 vo = *(const u32x4*)(prow + C_MQ + c);
            float* yy = y + 8 * h8; float* vv = vs + 8 * h8;
            yy[0] = bflo(yf.x) + bflo(yb.x); yy[1] = bfhi(yf.x) + bfhi(yb.x); yy[2] = bflo(yf.y) + bflo(yb.y); yy[3] = bfhi(yf.y) + bfhi(yb.y);
            yy[4] = bflo(yf.z) + bflo(yb.z); yy[5] = bfhi(yf.z) + bfhi(yb.z); yy[6] = bflo(yf.w) + bflo(yb.w); yy[7] = bfhi(yf.w) + bfhi(yb.w);
            vv[0] = bflo(vo.x); vv[1] = bfhi(vo.x); vv[2] = bflo(vo.y); vv[3] = bfhi(vo.y); vv[4] = bflo(vo.z); vv[5] = bfhi(vo.z); vv[6] = bflo(vo.w); vv[7] = bfhi(vo.w);
        }
        float s = 0.f;
#pragma unroll
        for (int j = 0; j < 16; ++j) s += y[j];
        const float ym = red4(s) * (1.f / 64.f);
        float s2 = 0.f;
#pragma unroll
        for (int j = 0; j < 16; ++j) { y[j] -= ym; s2 += y[j] * y[j]; }
        const float rstd = rsqrtf(red4(s2) * (1.f / 64.f) + LNX_EPS);
        unsigned outr[8];
#pragma unroll
        for (int h8 = 0; h8 < 2; ++h8) {
            const int c = c0 + 8 * h8;
            const u32x4 rz = *(const u32x4*)(prow + C_RZ + c);
            float o[8];
#pragma unroll
            for (int j = 0; j < 8; ++j) o[j] = y[8 * h8 + j] * rstd * plg[2 * h8 + (j >> 2)][j & 3] + plb[2 * h8 + (j >> 2)][j & 3] + bon * vs[8 * h8 + j];
            o[0] *= silu_f(bflo(rz.x)); o[1] *= silu_f(bfhi(rz.x)); o[2] *= silu_f(bflo(rz.y)); o[3] *= silu_f(bfhi(rz.y));
            o[4] *= silu_f(bflo(rz.z)); o[5] *= silu_f(bfhi(rz.z)); o[6] *= silu_f(bflo(rz.w)); o[7] *= silu_f(bfhi(rz.w));
            outr[4 * h8 + 0] = pk2(o[0], o[1]); outr[4 * h8 + 1] = pk2(o[2], o[3]); outr[4 * h8 + 2] = pk2(o[4], o[5]); outr[4 * h8 + 3] = pk2(o[6], o[7]);
        }
        *(u32x4*)(prow + 16 * lane) = (u32x4){outm[0], outm[1], outm[2], outm[3]};
        *(u32x4*)(prow + 16 * lane + 8) = (u32x4){outm[4], outm[5], outm[6], outm[7]};
        *(u32x4*)(prow + 1024 + c0) = (u32x4){outr[0], outr[1], outr[2], outr[3]};
        *(u32x4*)(prow + 1024 + c0 + 8) = (u32x4){outr[4], outr[5], outr[6], outr[7]};
    }
}

__device__ __forceinline__ void phase6(const Params& p) {
    const int tid = threadIdx.x, lane = tid & 63, wave = __builtin_amdgcn_readfirstlane(tid >> 6);
    const float* fg = p.in[I_FINALG];
    const bf16_t* XN = (const bf16_t*)(p.ws + WS_QKC);
    f32x4 g[4][2];
#pragma unroll
    for (int j = 0; j < 4; ++j) { g[j][0] = *(const f32x4*)(fg + 8 * lane + 512 * j); g[j][1] = *(const f32x4*)(fg + 8 * lane + 512 * j + 4); }
    for (int row = blockIdx.x * 8 + wave; row < MROWS; row += gridDim.x * 8) {
        u32x4 v[4]; float ss = 0.f;
#pragma unroll
        for (int j = 0; j < 4; ++j) v[j] = *(const u32x4*)(XN + (size_t)row * DM + 8 * lane + 512 * j);
        f32x4 a[4][2];
#pragma unroll
        for (int j = 0; j < 4; ++j) { a[j][0] = (f32x4){bflo(v[j].x), bfhi(v[j].x), bflo(v[j].y), bfhi(v[j].y)}; a[j][1] = (f32x4){bflo(v[j].z), bfhi(v[j].z), bflo(v[j].w), bfhi(v[j].w)};
            ss += (a[j][0].x * a[j][0].x + a[j][0].y * a[j][0].y) + (a[j][0].z * a[j][0].z + a[j][0].w * a[j][0].w) + (a[j][1].x * a[j][1].x + a[j][1].y * a[j][1].y) + (a[j][1].z * a[j][1].z + a[j][1].w * a[j][1].w); }
        const float rstd = rsqrtf(wave_sum(ss) * (1.f / DM) + EPS);
        float* o = p.out + (size_t)row * DM + 8 * lane;
#pragma unroll
        for (int j = 0; j < 4; ++j) { *(f32x4*)(o + 512 * j) = a[j][0] * rstd * g[j][0]; *(f32x4*)(o + 512 * j + 4) = a[j][1] * rstd * g[j][1]; }
    }
}

#define XB_TMO      128
#define XB_XCNT(j)  (256  + 64 * (j))
#define XB_XSUB(j)  (1280 + 64 * (j))
#define XB_XGEN(j)  (2304 + 64 * (j))
#define XB_TOP      3328
#define XB_TOPGEN   3392
#define XCD_BAR_WORDS 3456
#define XB_SPIN_CAP (1u << 18)
__device__ __forceinline__ unsigned xb_ld(unsigned* p)              { return __hip_atomic_load(p, __ATOMIC_RELAXED, __HIP_MEMORY_SCOPE_AGENT); }
__device__ __forceinline__ unsigned xb_add(unsigned* p, unsigned v) { return __hip_atomic_fetch_add(p, v, __ATOMIC_RELAXED, __HIP_MEMORY_SCOPE_AGENT); }
__device__ __forceinline__ unsigned xb_xcc_id() { return (unsigned)__builtin_amdgcn_s_getreg((3 << 11) | 20) & 0xFu; }
#define XB_SPIN(cond, bar) do { unsigned _sp = 0; while (cond) { __builtin_amdgcn_s_sleep(1); \
    if ((++_sp & 255u) == 0u) { if (xb_ld(&(bar)[XB_TMO])) break; if (_sp > XB_SPIN_CAP) { atomicAdd(&(bar)[XB_TMO], 1u); break; } } } } while (0)
struct XcdBarrier { unsigned* bar; unsigned x; volatile unsigned* st; };
__device__ __forceinline__ XcdBarrier xcd_barrier_post(unsigned* bar, volatile unsigned* st) {
    XcdBarrier b; b.bar = bar; b.x = xb_xcc_id(); b.st = st;
    if (threadIdx.x == 0) (void)xb_add(&bar[XB_XCNT(b.x)], 1u);
    return b;
}
__device__ __forceinline__ void xcd_barrier_complete(unsigned* bar, unsigned x, unsigned& nloc, unsigned& nx) {
    const unsigned G = gridDim.x * gridDim.y * gridDim.z;
    unsigned sum, cnt, mine, sp = 0u;
    for (;;) {
        sum = 0u; cnt = 0u; mine = 0u;
#pragma unroll
        for (unsigned j = 0; j < 16; ++j) { const unsigned c = xb_ld(&bar[XB_XCNT(j)]); sum += c; cnt += (c > 0u) ? 1u : 0u; mine = (j == x) ? c : mine; }
        if (sum == G) break;
        __builtin_amdgcn_s_sleep(1);
        if ((++sp & 255u) == 0u) { if (xb_ld(&bar[XB_TMO])) break; if (sp > XB_SPIN_CAP) { atomicAdd(&bar[XB_TMO], 1u); break; } }
    }
    nloc = mine > 0u ? mine : 1u; nx = cnt > 0u ? cnt : 1u;
}
__device__ __forceinline__ void xcd_barrier(const XcdBarrier& b) {
    asm volatile("s_waitcnt vmcnt(0)" ::: "memory");
    __syncthreads();
    if (threadIdx.x == 0) {
        unsigned* bar = b.bar;
        __builtin_amdgcn_s_waitcnt(0);
        unsigned nloc = b.st[0], nx = b.st[1];
        if (nloc == 0u) { xcd_barrier_complete(bar, b.x, nloc, nx); b.st[0] = nloc; b.st[1] = nx; }
        const unsigned old = xb_add(&bar[XB_XSUB(b.x)], 1u);
        const unsigned gen = old / nloc;
        if (old + 1u == (gen + 1u) * nloc) {
            __builtin_amdgcn_fence(__ATOMIC_RELEASE, "agent");
            asm volatile("s_waitcnt vmcnt(0)" ::: "memory");
            const unsigned og = xb_add(&bar[XB_TOP], 1u);
            const unsigned tg = og / nx;
            if (og + 1u == (tg + 1u) * nx) xb_add(&bar[XB_TOPGEN], 1u);
            else XB_SPIN(xb_ld(&bar[XB_TOPGEN]) == tg, bar);
            __builtin_amdgcn_fence(__ATOMIC_ACQUIRE, "agent");
            xb_add(&bar[XB_XGEN(b.x)], 1u);
            asm volatile("s_waitcnt vmcnt(0)" ::: "memory");
        } else {
            XB_SPIN(xb_ld(&bar[XB_XGEN(b.x)]) == gen, bar);
            __builtin_amdgcn_fence(__ATOMIC_ACQUIRE, "agent");
            asm volatile("s_waitcnt vmcnt(0)" ::: "memory");
        }
    }
    __syncthreads();
}

__global__ void __launch_bounds__(512, 2) mega_fwd(Params p) {
    extern __shared__ __attribute__((aligned(16))) unsigned char lds[];
    cg::grid_group grid = cg::this_grid();
    const int lo = p.ph_lo, hi = p.ph_hi;
#define IN(k) (lo <= (k) && (k) < hi)
    volatile unsigned* bst = (volatile unsigned*)(lds + LDS_BYTES - 16);
    if (threadIdx.x == 0) { bst[0] = 0u; bst[1] = 0u; }
    __syncthreads();
    XcdBarrier xbar; xbar.bar = (unsigned*)(p.ws + WS_BAR); xbar.x = 0; xbar.st = bst;
    if (hi - lo > 1) xbar = xcd_barrier_post((unsigned*)(p.ws + WS_BAR), bst);
    if (lo == 0x7fff) grid.sync();
#define SEAM(k) do { if (IN(k) && IN((k) + 1)) xcd_barrier(xbar); } while (0)
#ifndef SK0
    if (IN(0)) phase0(p, lds);
#endif
    SEAM(0);
#ifndef SK1
    if (IN(1)) phase1(p, lds);
#endif
    SEAM(1);
#ifndef SK2
    if (IN(2)) {
        pg8::Gemm g{(const bf16_t*)((unsigned char*)p.out + Y_H), (const bf16_t*)(p.ws + WS_WINT), MROWS, NPAD, DM, DM};
        pg8::StaticOrder S; S.init(MROWS, NPAD, gridDim.x, (int)blockIdx.x);
        pg8::EpiP E{(bf16_t*)(p.ws + WS_P), (float*)(p.ws + WS_G32)};
        pg8::gemm_phase<pg8::EpiP>((PG8_LAS unsigned char*)lds, g, S, E);
    }
#endif
    SEAM(2);
    if (IN(3)) phase_prep(p);
    SEAM(3);
#ifndef SK3
    if (IN(4)) phase3(p, lds);
#endif
    SEAM(4);
#ifndef SK4
    if (IN(5)) phase4(p);
#endif
    SEAM(5);
#ifndef SK5
    if (IN(6)) {
        pg8::Gemm g{(const bf16_t*)(p.ws + WS_P), (const bf16_t*)(p.ws + WS_WOUTT), MROWS, DM, DM, LDP};
        pg8::StaticOrder S; S.init(MROWS, DM, gridDim.x, (int)blockIdx.x);
        pg8::EpiRes E{p.in[I_XP], p.in[I_XS], (const float*)(p.ws + WS_MOD), (bf16_t*)(p.ws + WS_QKC)};
        pg8::gemm_phase<pg8::EpiRes>((PG8_LAS unsigned char*)lds, g, S, E);
    }
#endif
    SEAM(6);
#ifndef SK6
    if (IN(7)) phase6(p);
#endif
#undef IN
#undef SEAM
}

extern "C" void kernel_launch(void* const* d_in, const int* in_sizes, int n_in, void* d_out, int out_size, void* d_ws, size_t ws_size, hipStream_t stream) {
    static int state = 0;
    if (state == 0) {
        state = 1;
        if (n_in != 28 || ws_size < WS_END) { fprintf(stderr, "kernel_launch: unexpected n_in %d / ws_size %zu (need %zu)\n", n_in, ws_size, (size_t)WS_END); state = -1; }
        if (hipFuncSetAttribute((const void*)mega_fwd, hipFuncAttributeMaxDynamicSharedMemorySize, LDS_BYTES) != hipSuccess) { fprintf(stderr, "kernel_launch: hipFuncSetAttribute failed\n"); state = -1; }
        int per_cu = 0, dev = 0, cus = 0;
        (void)hipGetDevice(&dev); (void)hipDeviceGetAttribute(&cus, hipDeviceAttributeMultiprocessorCount, dev);
        if (hipOccupancyMaxActiveBlocksPerMultiprocessor(&per_cu, (const void*)mega_fwd, 512, LDS_BYTES) != hipSuccess || per_cu < 1 || cus < 256) { fprintf(stderr, "kernel_launch: occupancy %d x %d CUs cannot hold 256 workgroups\n", per_cu, cus); state = -1; }
        (void)hipGetLastError();
    }
    if (state < 0) return;
    if (hipMemsetAsync((char*)d_ws + WS_BAR, 0, 16384, stream) != hipSuccess) { fprintf(stderr, "kernel_launch: memset failed\n"); return; }
    Params p{};
    for (int i = 0; i < 28; ++i) p.in[i] = (const float*)d_in[i];
    p.out = (float*)d_out; p.ws = (unsigned char*)d_ws;
#if REP >= 0
    for (int k = 0; k < 8; ++k) for (int r = 0; r < (k == REP / 10 ? 2 : 1); ++r) { p.ph_lo = k; p.ph_hi = k + 1; p.sub = r ? REP % 10 : 0; hipLaunchKernelGGL(mega_fwd, dim3(256), dim3(512), LDS_BYTES, stream, p); }
#elif N_LAUNCHES == 1
    p.ph_lo = 0; p.ph_hi = 8;
    void* args[] = {&p};
    hipError_t e = hipLaunchCooperativeKernel((void*)mega_fwd, dim3(256), dim3(512), args, LDS_BYTES, stream);
    if (e != hipSuccess) fprintf(stderr, "cooperative launch failed: %s\n", hipGetErrorString(e));
#else
    for (int k = 0; k < 8; ++k) { p.ph_lo = k; p.ph_hi = k + 1; hipLaunchKernelGGL(mega_fwd, dim3(256), dim3(512), LDS_BYTES, stream, p); }
#endif
}
```
